# Optimizing an MI355X kernel written in HIP

```python
import math
import jax, jax.numpy as jnp
from jax import lax
import numpy as np

D_MODEL = 1024
BATCH = 4
SEQ = 4096
DEPTH = 2

HEAD_DIM = 64
EPS = 1e-6
A_HEADS = 8
A_KV_HEADS = 2
WINDOW = 128
BAND = 128
B_HEADS = 8
B_HEAD_DIM = 64
B_WIDTH = B_HEADS * B_HEAD_DIM
B_DECAY_RANK = 64
B_A_RANK = 64
B_GATE_RANK = 128
B_LN_EPS = 64e-5
C_HEADS = 8
C_KV_HEADS = 2
MOBA_BLOCK = 256
MOBA_TOPK = 3
C_QCHUNK = 128
D_HEADS = 8
IDX_HEADS = 4
IDX_DIM = 64
DSA_TOPK = 256
D_QCHUNK = 128
N_BUCKETS = 32
MAX_DISTANCE = 1024
BIAS_HEADS = 8
MEM_LEN = 256
X_HEADS = 4
X_HEAD_DIM = 128
X_WIDTH = X_HEADS * X_HEAD_DIM
D_FF = 4 * D_MODEL
A_Q = A_HEADS * HEAD_DIM
A_KV = A_KV_HEADS * HEAD_DIM
A_IN = A_Q + 2 * A_KV
B_IN = 3 * B_WIDTH + B_DECAY_RANK + B_A_RANK + B_GATE_RANK
EVEN_IN = A_IN + B_IN
C_Q = C_HEADS * HEAD_DIM
C_KV = C_KV_HEADS * HEAD_DIM
D_Q = D_HEADS * HEAD_DIM
ODD_IN = C_Q + 2 * C_KV + D_Q + 2 * HEAD_DIM + IDX_HEADS * IDX_DIM + IDX_DIM + IDX_HEADS
MIX_WIDTH = A_Q + B_WIDTH

kernel_name = 'hybrid_swa_rwkv7_moba_dsa_block'


def rms_norm(x, g):
    xf = x.astype(jnp.float32)
    y = xf * lax.rsqrt(jnp.mean(xf * xf, axis=-1, keepdims=True) + EPS)
    return (y * g.astype(jnp.float32)).astype(x.dtype)


def rel_bucket(dist):
    n = jnp.maximum(dist, 0)
    exact = N_BUCKETS // 2
    log_ratio = jnp.log(jnp.maximum(n, 1).astype(jnp.float32) / exact) / math.log(MAX_DISTANCE / exact)
    large = jnp.minimum(exact + (log_ratio * (N_BUCKETS - exact)).astype(jnp.int32), N_BUCKETS - 1)
    return jnp.where(n < exact, n, large)


def swa_sink_attention(q, k, v, sinks, rel_bias):
    Bsz, T = q.shape[:2]
    nb = T // BAND
    G = A_HEADS // A_KV_HEADS
    qb = q.reshape(Bsz, nb, BAND, A_KV_HEADS, G, HEAD_DIM)

    def with_prev(z):
        zb = z.reshape(Bsz, nb, BAND, A_KV_HEADS, HEAD_DIM)
        prev = jnp.pad(zb, ((0, 0), (1, 0), (0, 0), (0, 0), (0, 0)))[:, :-1]
        return jnp.concatenate([prev, zb], axis=2)

    kc, vc = with_prev(k), with_prev(v)
    scores = jnp.einsum('bnqhgd,bnkhd->bnhgqk', qb, kc).astype(jnp.float32) * HEAD_DIM ** -0.5
    qi = jnp.arange(BAND)[:, None]
    kj = jnp.arange(2 * BAND)[None, :]
    dist = qi + BAND - kj
    bias = rel_bias[rel_bucket(dist)].reshape(BAND, 2 * BAND, A_KV_HEADS, G).transpose(2, 3, 0, 1)
    first = (jnp.arange(nb) == 0)[:, None, None] & (kj < BAND)[None]
    mask = ((dist >= 0) & (dist < WINDOW))[None] & ~first
    logits = jnp.where(mask[None, :, None, None], scores + bias.astype(jnp.float32), -jnp.inf)
    sink = sinks.astype(jnp.float32).reshape(A_KV_HEADS, G)[None, None, :, :, None, None]
    m = jnp.maximum(jnp.max(logits, axis=-1, keepdims=True), sink)
    p = jnp.exp(logits - m)
    probs = p / (jnp.sum(p, axis=-1, keepdims=True) + jnp.exp(sink - m))
    out = jnp.einsum('bnhgqk,bnkhd->bnqhgd', probs.astype(v.dtype), vc)
    return out.reshape(Bsz, T, A_Q)


def rwkv7_time_mix(p, mu, w0, w2, a0, a2, g2, k_k, k_a, r_k, ln_w, ln_b):
    Bsz, T, _ = p.shape
    H, N, W = B_HEADS, B_HEAD_DIM, B_WIDTH
    p_prev = jnp.pad(p, ((0, 0), (1, 0), (0, 0)))[:, :-1]
    p = p + (p_prev - p) * mu
    r, k, v, w_lo, a_lo, g_lo = jnp.split(p, [W, 2 * W, 3 * W, 3 * W + B_DECAY_RANK, 3 * W + B_DECAY_RANK + B_A_RANK], axis=-1)
    w = -jax.nn.softplus(-(w0 + jnp.tanh(w_lo) @ w2).astype(jnp.float32)) - 0.5
    decay = jnp.exp(-jnp.exp(w))
    a = jax.nn.sigmoid((a0 + a_lo @ a2).astype(jnp.float32))
    g = jax.nn.sigmoid(g_lo) @ g2
    kk = (k * k_k).astype(jnp.float32).reshape(Bsz, T, H, N)
    kk = kk / jnp.maximum(jnp.sqrt(jnp.sum(kk * kk, axis=-1, keepdims=True)), 1e-12)
    k = k.astype(jnp.float32) * (1.0 + (a - 1.0) * k_a.astype(jnp.float32))

    def heads(z):
        return z.astype(jnp.float32).reshape(Bsz, T, H, N)

    rh, wh, kh, vh, ah = heads(r), heads(decay), heads(k), heads(v), heads(a)
    xs = tuple(jnp.moveaxis(z, 1, 0) for z in (rh, wh, kh, vh, kk, ah))

    def step(S, inp):
        r_t, w_t, k_t, v_t, kk_t, a_t = inp
        s_kk = jnp.einsum('bhvk,bhk->bhv', S, kk_t)
        S = S * w_t[:, :, None, :] - s_kk[..., None] * (kk_t * a_t)[:, :, None, :] + v_t[..., None] * k_t[:, :, None, :]
        return S, jnp.einsum('bhvk,bhk->bhv', S, r_t)

    S0 = jnp.zeros((Bsz, H, N, N), jnp.float32)
    _, y = lax.scan(step, S0, xs)
    y = jnp.moveaxis(y, 0, 1)
    mean = jnp.mean(y, axis=-1, keepdims=True)
    var = jnp.mean(jnp.square(y - mean), axis=-1, keepdims=True)
    yn = ((y - mean) * lax.rsqrt(var + B_LN_EPS)).reshape(Bsz, T, W) * ln_w.astype(jnp.float32) + ln_b.astype(jnp.float32)
    bonus = jnp.sum(rh * kh * r_k.astype(jnp.float32), axis=-1, keepdims=True) * vh
    out = (yn + bonus.reshape(Bsz, T, W)) * g.astype(jnp.float32)
    return out.astype(p.dtype)


def moba_attention(q, k, v, rel_bias):
    Bsz, T = q.shape[:2]
    G = C_HEADS // C_KV_HEADS
    nb = -(-T // MOBA_BLOCK)
    Tp = nb * MOBA_BLOCK

    def pad_t(z):
        return jnp.pad(z, ((0, 0), (0, Tp - T)) + ((0, 0),) * (z.ndim - 2))

    q, k, v = pad_t(q), pad_t(k), pad_t(v)
    kbh = jnp.moveaxis(k.reshape(Bsz, nb, MOBA_BLOCK, C_KV_HEADS, HEAD_DIM), 3, 1)
    vbh = jnp.moveaxis(v.reshape(Bsz, nb, MOBA_BLOCK, C_KV_HEADS, HEAD_DIM), 3, 1)
    kmean = jnp.mean(kbh.astype(jnp.float32), axis=3)
    n_sel = min(MOBA_TOPK, nb)
    nq = Tp // C_QCHUNK
    qc = jnp.moveaxis(q.reshape(Bsz, nq, C_QCHUNK, C_KV_HEADS, G, HEAD_DIM), 1, 0)
    rb = rel_bias.reshape(N_BUCKETS, C_KV_HEADS, G)
    bidx = jnp.arange(Bsz)[:, None, None, None]
    hidx = jnp.arange(C_KV_HEADS)[None, None, :, None]
    blk_ids = jnp.arange(nb)
    offs = jnp.arange(MOBA_BLOCK)
    scale = HEAD_DIM ** -0.5

    def one_chunk(args):
        qx, ci = args
        t = ci * C_QCHUNK + jnp.arange(C_QCHUNK)
        own = (ci * C_QCHUNK) // MOBA_BLOCK
        gate = jnp.einsum('bqhgd,bhnd->bqhn', qx.astype(jnp.float32), kmean)
        gate = jnp.where(blk_ids < own, gate, -jnp.inf)
        _, sel = lax.top_k(gate, n_sel)
        ok = sel < own
        kg = kbh[bidx, hidx, sel]
        vg = vbh[bidx, hidx, sel]
        s_sel = jnp.einsum('bqhgd,bqhnkd->bqhgnk', qx, kg).astype(jnp.float32) * scale
        key_pos = sel[..., None] * MOBA_BLOCK + offs
        b_sel = rb[rel_bucket(t[None, :, None, None, None] - key_pos), hidx[..., None]]
        s_sel = jnp.where(ok[:, :, :, None, :, None], s_sel + jnp.moveaxis(b_sel, -1, 3).astype(jnp.float32), -jnp.inf)
        k_own = lax.dynamic_index_in_dim(kbh, own, axis=2, keepdims=False)
        v_own = lax.dynamic_index_in_dim(vbh, own, axis=2, keepdims=False)
        s_own = jnp.einsum('bqhgd,bhkd->bqhgk', qx, k_own).astype(jnp.float32) * scale
        dist = t[:, None] - (own * MOBA_BLOCK + offs)[None, :]
        b_own = jnp.moveaxis(rel_bias[rel_bucket(dist)].reshape(C_QCHUNK, MOBA_BLOCK, C_KV_HEADS, G), 1, 3)
        s_own = jnp.where((dist >= 0)[:, None, None, :], s_own + b_own.astype(jnp.float32), -jnp.inf)
        logits = jnp.concatenate([s_sel.reshape(Bsz, C_QCHUNK, C_KV_HEADS, G, n_sel * MOBA_BLOCK), s_own], axis=-1)
        probs = jax.nn.softmax(logits, axis=-1).astype(v.dtype)
        p_sel = probs[..., :n_sel * MOBA_BLOCK].reshape(Bsz, C_QCHUNK, C_KV_HEADS, G, n_sel, MOBA_BLOCK)
        p_own = probs[..., n_sel * MOBA_BLOCK:]
        return (jnp.einsum('bqhgnk,bqhnkd->bqhgd', p_sel, vg)
                + jnp.einsum('bqhgk,bhkd->bqhgd', p_own, v_own))

    out = lax.map(one_chunk, (qc, jnp.arange(nq)))
    return jnp.moveaxis(out, 0, 1).reshape(Bsz, Tp, C_Q)[:, :T]


def dsa_attention(q, k, v, q_idx, k_idx, w_idx, rel_bias):
    Bsz, T = q.shape[:2]
    n_sel = min(DSA_TOPK, T // 4)
    nq = T // D_QCHUNK
    w_idx = w_idx.astype(jnp.float32) * (IDX_HEADS * IDX_DIM) ** -0.5

    def chunks(z):
        return jnp.moveaxis(z.reshape((Bsz, nq, D_QCHUNK) + z.shape[2:]), 1, 0)

    bidx = jnp.arange(Bsz)[:, None, None]
    key_pos = jnp.arange(T)

    def one_chunk(args):
        qx, qix, wx, ci = args
        t = ci * D_QCHUNK + jnp.arange(D_QCHUNK)
        rel = jax.nn.relu(jnp.einsum('bqhd,bsd->bqhs', qix, k_idx).astype(jnp.float32))
        score = jnp.einsum('bqhs,bqh->bqs', rel, wx)
        score = jnp.where(key_pos[None, None, :] <= t[None, :, None], score, -jnp.inf)
        _, sel = lax.top_k(score, n_sel)
        ok = sel <= t[None, :, None]
        kg = k[bidx, sel]
        vg = v[bidx, sel]
        logits = jnp.einsum('bqhd,bqkd->bqhk', qx, kg).astype(jnp.float32) * HEAD_DIM ** -0.5
        bias = jnp.moveaxis(rel_bias[rel_bucket(t[None, :, None] - sel)], -1, 2).astype(jnp.float32)
        logits = jnp.where(ok[:, :, None, :], logits + bias, -jnp.inf)
        probs = jax.nn.softmax(logits, axis=-1).astype(v.dtype)
        return jnp.einsum('bqhk,bqkd->bqhd', probs, vg)

    out = lax.map(one_chunk, (chunks(q), chunks(q_idx), chunks(w_idx), jnp.arange(nq)))
    return jnp.moveaxis(out, 0, 1).reshape(Bsz, T, D_Q)


def memory_cross_attention(h, mem_n, wq, wkv, wo):
    Bsz, T, _ = h.shape
    M = mem_n.shape[1]
    q = (h @ wq).reshape(Bsz, T, X_HEADS, X_HEAD_DIM)
    kv = (mem_n @ wkv).reshape(Bsz, M, 2, X_HEADS, X_HEAD_DIM)
    k, v = kv[:, :, 0], kv[:, :, 1]
    scores = jnp.einsum('bthd,bmhd->bhtm', q, k).astype(jnp.float32) * X_HEAD_DIM ** -0.5
    probs = jax.nn.softmax(scores, axis=-1).astype(v.dtype)
    out = jnp.einsum('bhtm,bmhd->bthd', probs, v).reshape(Bsz, T, X_WIDTH)
    return out @ wo


def squared_relu_mlp(h, w1, w2):
    return jnp.square(jax.nn.relu(h @ w1)) @ w2


def setup_inputs(seed: int = 0) -> dict:
    key = jax.random.key(seed)
    ks = iter(jax.random.split(key, 32))
    NE = (DEPTH + 1) // 2
    NO = DEPTH // 2
    D = D_MODEL

    def nrm(shape, scale):
        return jax.random.normal(next(ks), shape, jnp.float32) * scale

    def unif(shape, lo, hi):
        return jax.random.uniform(next(ks), shape, jnp.float32, lo, hi)

    return {
        'x': nrm((BATCH, SEQ, D), 1.0),
        'mem': nrm((BATCH, MEM_LEN, D), 1.0),
        'rel_bias': nrm((N_BUCKETS, BIAS_HEADS), 0.5),
        'norm_gains': 1.0 + nrm((DEPTH, 6, D), 0.02),
        'mix_w_out': nrm((DEPTH, MIX_WIDTH, D), MIX_WIDTH ** -0.5),
        'mem_norm': 1.0 + nrm((DEPTH, D), 0.02),
        'x_wq': nrm((DEPTH, D, X_WIDTH), D ** -0.5),
        'x_wkv': nrm((DEPTH, D, 2 * X_WIDTH), D ** -0.5),
        'x_wo': nrm((DEPTH, X_WIDTH, D), X_WIDTH ** -0.5),
        'ff_w1': nrm((DEPTH, D, D_FF), D ** -0.5),
        'ff_w2': nrm((DEPTH, D_FF, D), D_FF ** -0.5),
        'ev_w_in': nrm((NE, D, EVEN_IN), D ** -0.5),
        'a_sinks': nrm((NE, A_HEADS), 0.5),
        'b_mu': unif((NE, B_IN), 0.2, 0.8),
        'b_w0': unif((NE, B_WIDTH), -6.0, 1.0),
        'b_w2': nrm((NE, B_DECAY_RANK, B_WIDTH), 0.1),
        'b_a0': nrm((NE, B_WIDTH), 0.1),
        'b_a2': nrm((NE, B_A_RANK, B_WIDTH), 0.5 * B_A_RANK ** -0.5),
        'b_g2': nrm((NE, B_GATE_RANK, B_WIDTH), B_GATE_RANK ** -0.5),
        'b_k_k': 0.85 + nrm((NE, B_WIDTH), 0.02),
        'b_k_a': 1.0 + nrm((NE, B_WIDTH), 0.02),
        'b_r_k': nrm((NE, B_HEADS, B_HEAD_DIM), 0.1),
        'b_ln_w': 1.0 + nrm((NE, B_WIDTH), 0.02),
        'b_ln_b': nrm((NE, B_WIDTH), 0.02),
        'od_w_in': nrm((NO, D, ODD_IN), D ** -0.5),
        'd_kidx_norm': 1.0 + nrm((NO, IDX_DIM), 0.02),
    }


def reference(x, mem, rel_bias, norm_gains, mix_w_out, mem_norm, x_wq, x_wkv, x_wo, ff_w1, ff_w2,
              ev_w_in, a_sinks, b_mu, b_w0, b_w2, b_a0, b_a2, b_g2, b_k_k, b_k_a, b_r_k, b_ln_w, b_ln_b,
              od_w_in, d_kidx_norm):
    Bsz, T, _ = x.shape
    for layer in range(DEPTH):
        i = layer // 2
        g = norm_gains[layer]
        h = rms_norm(x, g[0])
        if layer % 2 == 0:
            p = h @ ev_w_in[i]
            qa, ka, va, pb = jnp.split(p, [A_Q, A_Q + A_KV, A_IN], axis=-1)
            ya = swa_sink_attention(qa.reshape(Bsz, T, A_HEADS, HEAD_DIM),
                                    ka.reshape(Bsz, T, A_KV_HEADS, HEAD_DIM),
                                    va.reshape(Bsz, T, A_KV_HEADS, HEAD_DIM), a_sinks[i], rel_bias)
            yb = rwkv7_time_mix(pb, b_mu[i], b_w0[i], b_w2[i], b_a0[i], b_a2[i], b_g2[i],
                                b_k_k[i], b_k_a[i], b_r_k[i], b_ln_w[i], b_ln_b[i])
            y = jnp.concatenate([ya, yb], axis=-1)
        else:
            p = h @ od_w_in[i]
            cuts = np.cumsum([C_Q, C_KV, C_KV, D_Q, HEAD_DIM, HEAD_DIM, IDX_HEADS * IDX_DIM, IDX_DIM]).tolist()
            qc, kc, vc, qd, kd, vd, qi, ki, wi = jnp.split(p, cuts, axis=-1)
            yc = moba_attention(qc.reshape(Bsz, T, C_HEADS, HEAD_DIM),
                                kc.reshape(Bsz, T, C_KV_HEADS, HEAD_DIM),
                                vc.reshape(Bsz, T, C_KV_HEADS, HEAD_DIM), rel_bias)
            yd = dsa_attention(qd.reshape(Bsz, T, D_HEADS, HEAD_DIM), kd, vd,
                               qi.reshape(Bsz, T, IDX_HEADS, IDX_DIM), rms_norm(ki, d_kidx_norm[i]), wi, rel_bias)
            y = jnp.concatenate([yc, yd], axis=-1)
        x = x + rms_norm(y @ mix_w_out[layer], g[1])
        h = rms_norm(x, g[2])
        x = x + rms_norm(memory_cross_attention(h, rms_norm(mem, mem_norm[layer]), x_wq[layer], x_wkv[layer], x_wo[layer]), g[3])
        h = rms_norm(x, g[4])
        x = x + rms_norm(squared_relu_mlp(h, ff_w1[layer], ff_w2[layer]), g[5])
    return x
```

```cpp
#ifndef CPU_EMU
#include <hip/hip_runtime.h>
#endif
#include <stdint.h>
#include <math.h>
#include <stdio.h>

#ifndef SEQ_T
#define SEQ_T 4096
#endif
#ifndef BATCH_B
#define BATCH_B 4
#endif

namespace {
constexpr int T = SEQ_T, NB = BATCH_B, M = NB * T, D = 1024;
constexpr int EVEN_IN = 2560, ODD_IN = 1732, ODD_PAD = 1792, DFF = 4096, MEM = 256;
constexpr int DSA_K = (T / 4 < 256) ? T / 4 : 256;
constexpr int NBLK = T / 256;
constexpr float EPS = 1e-6f;
constexpr int O_QC = 0, O_KC = 512, O_VC = 640, O_QD = 768, O_KD = 1280, O_VD = 1344, O_QI = 1408, O_KI = 1664, O_WI = 1728;
constexpr int E_QA = 0, E_KA = 512, E_VA = 640, E_PB = 768;

typedef _Float16 half_t;
typedef _Float16 h8 __attribute__((ext_vector_type(8)));
typedef _Float16 h4 __attribute__((ext_vector_type(4)));
typedef float f4 __attribute__((ext_vector_type(4)));

__device__ __forceinline__ f4 mfma16(h8 a, h8 b, f4 c) {
#ifdef CPU_EMU
    return emu_mfma_16x16x32_f16(a, b, c);
#else
    return __builtin_amdgcn_mfma_f32_16x16x32_f16(a, b, c, 0, 0, 0);
#endif
}
__device__ __forceinline__ float bcast_lane(float v, int lane) {
#ifdef CPU_EMU
    return __shfl(v, lane);
#else
    return __builtin_bit_cast(float, __builtin_amdgcn_readlane(__builtin_bit_cast(int, v), lane));
#endif
}
__device__ __forceinline__ float fast_exp(float x) { return __expf(x); }

struct P {
    const float *x, *mem, *rel_bias, *norm_gains, *mix_w_out, *mem_norm, *x_wq, *x_wkv, *x_wo, *ff_w1, *ff_w2, *ev_w_in, *a_sinks, *b_mu, *b_w0,
        *b_w2, *b_a0, *b_a2, *b_g2, *b_k_k, *b_k_a, *b_r_k, *b_ln_w, *b_ln_b, *od_w_in, *d_kidx_norm;
    float* out;
    half_t *wt_ev, *wt_od, *wt_mix, *wt_q, *wt_kv, *wt_o, *wt_f1, *wt_f2;
    half_t *h, *o, *p, *y, *u, *xq, *xo, *memn, *memkv, *vT, *memvT, *kin, *rwL, *rwA, *rwG;
    float *rwY, *kmean, *scores, *bias_dist;
    unsigned short *mmask, *dsel;
};

__global__ void __launch_bounds__(256) k_transpose_w(const float* __restrict__ W, int K, int N, half_t* __restrict__ Wt, int Npad) {
    __shared__ float tile[64][65];
    const int nk = K / 64, nn = Npad / 64;
    for (int t = blockIdx.x; t < nk * nn; t += gridDim.x) {
        const int k0 = (t % nk) * 64, n0 = (t / nk) * 64;
        __syncthreads();
        for (int i = threadIdx.x; i < 64 * 64; i += 256) {
            int r = i >> 6, c = i & 63;
            tile[r][c] = (n0 + c < N) ? W[(long)(k0 + r) * N + n0 + c] : 0.f;
        }
        __syncthreads();
        for (int i = threadIdx.x; i < 64 * 64; i += 256) {
            int r = i >> 6, c = i & 63;
            Wt[(long)(n0 + r) * K + k0 + c] = (half_t)tile[c][r];
        }
    }
}

__device__ __forceinline__ int rel_bucket(int n) {
    if (n < 16) return n < 0 ? 0 : n;
    const int thr[15] = {21, 27, 35, 46, 59, 77, 99, 128, 166, 216, 280, 363, 470, 609, 790};
    int b = 16;
#pragma unroll
    for (int i = 0; i < 15; ++i) b += (n >= thr[i]) ? 1 : 0;
    return b;
}
__global__ void __launch_bounds__(256) k_bias_table(const float* __restrict__ rel_bias, float* __restrict__ bias_dist) {
    for (int i = blockIdx.x * 256 + threadIdx.x; i < 8 * 4096; i += gridDim.x * 256) {
        int hh = i >> 12, d = i & 4095;
        bias_dist[i] = rel_bias[rel_bucket(d) * 8 + hh];
    }
}

__device__ __forceinline__ float wave_sum(float v) {
#pragma unroll
    for (int o = 32; o >= 1; o >>= 1) v += __shfl_xor(v, o);
    return v;
}
__global__ void __launch_bounds__(256) k_rmsnorm(const float* __restrict__ x, const float* __restrict__ g, half_t* __restrict__ h, int rows) {
    const int lane = threadIdx.x & 63, w = threadIdx.x >> 6;
    for (int r = blockIdx.x * 4 + w; r < rows; r += gridDim.x * 4) {
        const float* xr = x + (long)r * D;
        f4 v[4]; float ss = 0.f;
#pragma unroll
        for (int i = 0; i < 4; ++i) { v[i] = *(const f4*)(xr + i * 256 + lane * 4); ss += v[i][0] * v[i][0] + v[i][1] * v[i][1] + v[i][2] * v[i][2] + v[i][3] * v[i][3]; }
        ss = wave_sum(ss);
        const float rs = rsqrtf(ss * (1.0f / D) + EPS);
#pragma unroll
        for (int i = 0; i < 4; ++i) {
            f4 gg = *(const f4*)(g + i * 256 + lane * 4); h4 o;
#pragma unroll
            for (int j = 0; j < 4; ++j) o[j] = (half_t)(v[i][j] * rs * gg[j]);
            *(h4*)(h + (long)r * D + i * 256 + lane * 4) = o;
        }
    }
}
__global__ void __launch_bounds__(256) k_post(const float* x, const half_t* o, const float* __restrict__ gpost, const float* __restrict__ gpre,
                                              float* xout, half_t* h, int rows) {
    const int lane = threadIdx.x & 63, w = threadIdx.x >> 6;
    for (int r = blockIdx.x * 4 + w; r < rows; r += gridDim.x * 4) {
        const half_t* orow = o + (long)r * D; const float* xr = x + (long)r * D;
        f4 v[4]; float ss = 0.f;
#pragma unroll
        for (int i = 0; i < 4; ++i) { h4 t4 = *(const h4*)(orow + i * 256 + lane * 4); v[i] = (f4){(float)t4[0], (float)t4[1], (float)t4[2], (float)t4[3]}; ss += v[i][0] * v[i][0] + v[i][1] * v[i][1] + v[i][2] * v[i][2] + v[i][3] * v[i][3]; }
        ss = wave_sum(ss);
        const float rs = rsqrtf(ss * (1.0f / D) + EPS);
        float s2 = 0.f;
#pragma unroll
        for (int i = 0; i < 4; ++i) {
            f4 gg = *(const f4*)(gpost + i * 256 + lane * 4); f4 xv = *(const f4*)(xr + i * 256 + lane * 4);
#pragma unroll
            for (int j = 0; j < 4; ++j) { v[i][j] = xv[j] + v[i][j] * rs * gg[j]; s2 += v[i][j] * v[i][j]; }
            *(f4*)(xout + (long)r * D + i * 256 + lane * 4) = v[i];
        }
        if (gpre) {
            s2 = wave_sum(s2);
            const float r2 = rsqrtf(s2 * (1.0f / D) + EPS);
#pragma unroll
            for (int i = 0; i < 4; ++i) {
                f4 gg = *(const f4*)(gpre + i * 256 + lane * 4); h4 ov;
#pragma unroll
                for (int j = 0; j < 4; ++j) ov[j] = (half_t)(v[i][j] * r2 * gg[j]);
                *(h4*)(h + (long)r * D + i * 256 + lane * 4) = ov;
            }
        }
    }
}

constexpr int EPI_F16 = 0, EPI_F32 = 1, EPI_RELU2 = 2;
constexpr int GLD = 72;
template <int EPI>
__device__ void gemm_tile(const half_t* __restrict__ A, int lda, const half_t* __restrict__ Bt, int ldb, int K, void* __restrict__ C, int ldc, int m0, int n0, half_t* smem) {
    half_t* sA = smem; half_t* sB = smem + 128 * GLD;
    const int tid = threadIdx.x, lane = tid & 63, w = tid >> 6, wr = w >> 1, wc = w & 1, lr = lane & 15, lg = lane >> 4;
    const int ldrow = tid >> 3, ldch = tid & 7;
    f4 acc[4][4];
#pragma unroll
    for (int i = 0; i < 4; ++i)
#pragma unroll
        for (int j = 0; j < 4; ++j) acc[i][j] = (f4){0.f, 0.f, 0.f, 0.f};
    h8 ra[4], rb[4];
    const half_t* Ag = A + (long)(m0 + ldrow) * lda + ldch * 8;
    const half_t* Bg = Bt + (long)(n0 + ldrow) * ldb + ldch * 8;
#pragma unroll
    for (int i = 0; i < 4; ++i) { ra[i] = *(const h8*)(Ag + (long)i * 32 * lda); rb[i] = *(const h8*)(Bg + (long)i * 32 * ldb); }
    const int nk = K / 64;
    for (int kt = 0; kt < nk; ++kt) {
        __syncthreads();
#pragma unroll
        for (int i = 0; i < 4; ++i) { *(h8*)(sA + (ldrow + i * 32) * GLD + ldch * 8) = ra[i]; *(h8*)(sB + (ldrow + i * 32) * GLD + ldch * 8) = rb[i]; }
        __syncthreads();
        if (kt + 1 < nk) {
#pragma unroll
            for (int i = 0; i < 4; ++i) { ra[i] = *(const h8*)(Ag + (long)i * 32 * lda + (kt + 1) * 64); rb[i] = *(const h8*)(Bg + (long)i * 32 * ldb + (kt + 1) * 64); }
        }
#pragma unroll
        for (int ks = 0; ks < 2; ++ks) {
            h8 fa[4], fb[4];
#pragma unroll
            for (int i = 0; i < 4; ++i) { fa[i] = *(const h8*)(sA + (wr * 64 + i * 16 + lr) * GLD + ks * 32 + lg * 8); fb[i] = *(const h8*)(sB + (wc * 64 + i * 16 + lr) * GLD + ks * 32 + lg * 8); }
#pragma unroll
            for (int i = 0; i < 4; ++i)
#pragma unroll
                for (int j = 0; j < 4; ++j) acc[i][j] = mfma16(fb[j], fa[i], acc[i][j]);
        }
    }
#pragma unroll
    for (int i = 0; i < 4; ++i)
#pragma unroll
        for (int j = 0; j < 4; ++j) {
            const long row = m0 + wr * 64 + i * 16 + lr; const int col = n0 + wc * 64 + j * 16 + 4 * lg;
            f4 v = acc[i][j];
            if (EPI == EPI_F32) { *(f4*)((float*)C + row * ldc + col) = v; }
            else {
                h4 o;
#pragma unroll
                for (int r = 0; r < 4; ++r) { float t = v[r]; if (EPI == EPI_RELU2) { t = fmaxf(t, 0.f); t = t * t; } o[r] = (half_t)t; }
                *(h4*)((half_t*)C + row * ldc + col) = o;
            }
        }
}
template <int EPI>
__global__ void __launch_bounds__(256) k_gemm(const half_t* __restrict__ A, int lda, const half_t* __restrict__ Bt, int ldb, int Mr, int N, int K, void* __restrict__ C, int ldc) {
    __shared__ __attribute__((aligned(16))) half_t smem[2 * 128 * GLD];
    const int nm = Mr / 128, nn = N / 128;
    for (int t = blockIdx.x; t < nm * nn; t += gridDim.x) gemm_tile<EPI>(A, lda, Bt, ldb, K, C, ldc, (t % nm) * 128, (t / nm) * 128, smem);
}

__global__ void __launch_bounds__(256) k_transpose_cols(const half_t* __restrict__ src, int ld, int c0, int nc, int tt, int nb, half_t* __restrict__ dst) {
    __shared__ half_t tile[64][66];
    const int ntt = tt / 64, ncc = nc / 64, total = nb * ntt * ncc;
    for (int t = blockIdx.x; t < total; t += gridDim.x) {
        const int b = t / (ntt * ncc), r = t % (ntt * ncc), t0 = (r / ncc) * 64, cc0 = (r % ncc) * 64;
        __syncthreads();
        for (int i = threadIdx.x; i < 4096; i += 256) { int rr = i >> 6, c = i & 63; tile[rr][c] = src[((long)b * tt + t0 + rr) * ld + c0 + cc0 + c]; }
        __syncthreads();
        for (int i = threadIdx.x; i < 4096; i += 256) { int c = i >> 6, rr = i & 63; dst[((long)b * nc + cc0 + c) * tt + t0 + rr] = tile[rr][c]; }
    }
}

template <int DT>
__device__ __forceinline__ void attn_step(f4 s0, f4 s1, const h8 (&vf)[DT], float& m, float& l, f4 (&o)[DT]) {
    float mx = fmaxf(fmaxf(fmaxf(s0[0], s0[1]), fmaxf(s0[2], s0[3])), fmaxf(fmaxf(s1[0], s1[1]), fmaxf(s1[2], s1[3])));
    mx = fmaxf(mx, __shfl_xor(mx, 16)); mx = fmaxf(mx, __shfl_xor(mx, 32));
    const float mn = fmaxf(m, mx);
    const float ms = (mn == -INFINITY) ? 0.f : mn;
    const float alpha = fast_exp(m - ms);
    h8 pb; float ps = 0.f;
#pragma unroll
    for (int r = 0; r < 4; ++r) { float p0 = fast_exp(s0[r] - ms), p1 = fast_exp(s1[r] - ms); ps += p0 + p1; pb[r] = (half_t)p0; pb[4 + r] = (half_t)p1; }
    l = l * alpha + ps;
#pragma unroll
    for (int dt = 0; dt < DT; ++dt) { o[dt] = o[dt] * alpha; o[dt] = mfma16(vf[dt], pb, o[dt]); }
    m = mn;
}

__device__ void swa_wave(const P& p, int b, int t0, int hh) {
    const int lane = threadIdx.x & 63, lr = lane & 15, lg = lane >> 4, kvh = hh >> 2;
    const half_t* pp = p.p; const int ld = EVEN_IN;
    const int tq = t0 + lr;
    h8 qf[2];
#pragma unroll
    for (int c = 0; c < 2; ++c) qf[c] = *(const h8*)(pp + ((long)b * T + tq) * ld + E_QA + hh * 64 + c * 32 + lg * 8);
    const float* bd = p.bias_dist + hh * 4096;
    float m = -INFINITY, l = 0.f; f4 o[4];
#pragma unroll
    for (int i = 0; i < 4; ++i) o[i] = (f4){0.f, 0.f, 0.f, 0.f};
    for (int st = 0; st < 5; ++st) {
        const int s0 = t0 - 144 + 32 * st;
        if (s0 + 31 < 0) continue;
        f4 sv[2];
#pragma unroll
        for (int tl = 0; tl < 2; ++tl) {
            int key = s0 + tl * 16 + lr; key = key < 0 ? 0 : key;
            f4 acc = (f4){0.f, 0.f, 0.f, 0.f};
#pragma unroll
            for (int c = 0; c < 2; ++c) { h8 kf = *(const h8*)(pp + ((long)b * T + key) * ld + E_KA + kvh * 64 + c * 32 + lg * 8); acc = mfma16(kf, qf[c], acc); }
#pragma unroll
            for (int r = 0; r < 4; ++r) { int ks = s0 + tl * 16 + 4 * lg + r, dist = tq - ks; bool ok = ks >= 0 && dist >= 0 && dist < 128; acc[r] = ok ? acc[r] * 0.125f + bd[dist] : -INFINITY; }
            sv[tl] = acc;
        }
        h8 vf[4];
#pragma unroll
        for (int dt = 0; dt < 4; ++dt) {
            const half_t* vr = p.vT + ((long)b * 128 + kvh * 64 + dt * 16 + lr) * T;
            int k0 = s0 + 4 * lg, k1 = s0 + 16 + 4 * lg; k0 = k0 < 0 ? 0 : k0; k1 = k1 < 0 ? 0 : k1;
            h4 a = *(const h4*)(vr + k0), bb = *(const h4*)(vr + k1);
            vf[dt] = (h8){a[0], a[1], a[2], a[3], bb[0], bb[1], bb[2], bb[3]};
        }
        attn_step<4>(sv[0], sv[1], vf, m, l, o);
    }
    l += __shfl_xor(l, 16); l += __shfl_xor(l, 32);
    const float sink = p.a_sinks[hh];
    const float mf = fmaxf(m, sink), sc = fast_exp(m - mf), inv = sc / (l * sc + fast_exp(sink - mf));
#pragma unroll
    for (int dt = 0; dt < 4; ++dt) {
        h4 ov;
#pragma unroll
        for (int r = 0; r < 4; ++r) ov[r] = (half_t)(o[dt][r] * inv);
        *(h4*)(p.y + ((long)b * T + tq) * D + hh * 64 + dt * 16 + 4 * lg) = ov;
    }
}
__global__ void __launch_bounds__(256) k_swa(P p) {
    const int w = threadIdx.x >> 6, nt = T / 16, total = NB * nt * 8;
    for (int u = blockIdx.x * 4 + w; u < total; u += gridDim.x * 4) { int hh = u & 7, r = u >> 3; swa_wave(p, r / nt, (r % nt) * 16, hh); }
}

__device__ void xattn_wave(const P& p, int layer, int b, int t0, int hx) {
    const int lane = threadIdx.x & 63, lr = lane & 15, lg = lane >> 4;
    const int tq = t0 + lr;
    const half_t* kv = p.memkv; (void)layer;
    const half_t* vt = p.memvT;
    h8 qf[4];
#pragma unroll
    for (int c = 0; c < 4; ++c) qf[c] = *(const h8*)(p.xq + ((long)b * T + tq) * 512 + hx * 128 + c * 32 + lg * 8);
    float m = -INFINITY, l = 0.f; f4 o[8];
#pragma unroll
    for (int i = 0; i < 8; ++i) o[i] = (f4){0.f, 0.f, 0.f, 0.f};
    const float scale = 0.08838834764831845f;
    for (int st = 0; st < MEM / 32; ++st) {
        const int s0 = st * 32;
        f4 sv[2];
#pragma unroll
        for (int tl = 0; tl < 2; ++tl) {
            const int key = s0 + tl * 16 + lr;
            f4 acc = (f4){0.f, 0.f, 0.f, 0.f};
#pragma unroll
            for (int c = 0; c < 4; ++c) { h8 kf = *(const h8*)(kv + ((long)b * MEM + key) * 1024 + hx * 128 + c * 32 + lg * 8); acc = mfma16(kf, qf[c], acc); }
            sv[tl] = acc * scale;
        }
        h8 vf[8];
#pragma unroll
        for (int dt = 0; dt < 8; ++dt) {
            const half_t* vr = vt + ((long)b * 512 + hx * 128 + dt * 16 + lr) * MEM;
            h4 a = *(const h4*)(vr + s0 + 4 * lg), bb = *(const h4*)(vr + s0 + 16 + 4 * lg);
            vf[dt] = (h8){a[0], a[1], a[2], a[3], bb[0], bb[1], bb[2], bb[3]};
        }
        attn_step<8>(sv[0], sv[1], vf, m, l, o);
    }
    l += __shfl_xor(l, 16); l += __shfl_xor(l, 32);
    const float inv = 1.0f / l;
#pragma unroll
    for (int dt = 0; dt < 8; ++dt) {
        h4 ov;
#pragma unroll
        for (int r = 0; r < 4; ++r) ov[r] = (half_t)(o[dt][r] * inv);
        *(h4*)(p.xo + ((long)b * T + tq) * 512 + hx * 128 + dt * 16 + 4 * lg) = ov;
    }
}
__global__ void __launch_bounds__(256) k_xattn(P p, int layer) {
    const int w = threadIdx.x >> 6, nt = T / 16, total = NB * nt * 4;
    for (int u = blockIdx.x * 4 + w; u < total; u += gridDim.x * 4) { int hx = u & 3, r = u >> 2; xattn_wave(p, layer, r / nt, (r % nt) * 16, hx); }
}

__device__ __forceinline__ float tshift(const half_t* pp, long row, int tt, int col, float mu) {
    const float cur = (float)pp[row * EVEN_IN + E_PB + col];
    const float prv = tt > 0 ? (float)pp[(row - 1) * EVEN_IN + E_PB + col] : 0.f;
    return cur + (prv - cur) * mu;
}
__global__ void __launch_bounds__(256) k_rwkv_prep(P p) {
    __shared__ float lo[16][256];
    const int tid = threadIdx.x;
    for (int tb = blockIdx.x; tb < M / 16; tb += gridDim.x) {
        const int row0 = tb * 16;
        __syncthreads();
        for (int i = tid; i < 16 * 256; i += 256) {
            const int tk = i >> 8, c = i & 255; const long row = row0 + tk; const int tt = (int)(row % T);
            const float v = tshift(p.p, row, tt, 1536 + c, p.b_mu[1536 + c]);
            lo[tk][c] = c < 64 ? tanhf(v) : (c < 128 ? v : 1.0f / (1.0f + expf(-v)));
        }
        __syncthreads();
        float aw[2][16], aa[2][16], ag[2][16];
#pragma unroll
        for (int cc = 0; cc < 2; ++cc)
#pragma unroll
            for (int tk = 0; tk < 16; ++tk) { aw[cc][tk] = 0.f; aa[cc][tk] = 0.f; ag[cc][tk] = 0.f; }
        for (int j = 0; j < 64; ++j) {
#pragma unroll
            for (int cc = 0; cc < 2; ++cc) {
                const int c = tid + cc * 256; const float w2 = p.b_w2[j * 512 + c], a2 = p.b_a2[j * 512 + c];
#pragma unroll
                for (int tk = 0; tk < 16; ++tk) { aw[cc][tk] += lo[tk][j] * w2; aa[cc][tk] += lo[tk][64 + j] * a2; }
            }
        }
        for (int j = 0; j < 128; ++j) {
#pragma unroll
            for (int cc = 0; cc < 2; ++cc) {
                const int c = tid + cc * 256; const float g2 = p.b_g2[j * 512 + c];
#pragma unroll
                for (int tk = 0; tk < 16; ++tk) ag[cc][tk] += lo[tk][128 + j] * g2;
            }
        }
#pragma unroll
        for (int tk = 0; tk < 16; ++tk) {
            const long row = row0 + tk;
#pragma unroll
            for (int cc = 0; cc < 2; ++cc) {
                const int c = tid + cc * 256;
                const float wr = p.b_w0[c] + aw[cc][tk];
                const float sp = (-wr > 20.f) ? -wr : log1pf(expf(-wr));
                const float lam = expf(-sp - 0.5f);
                const float a = 1.0f / (1.0f + expf(-(p.b_a0[c] + aa[cc][tk])));
                p.rwL[row * 512 + c] = (half_t)lam;
                p.rwA[row * 512 + c] = (half_t)a;
                p.rwG[row * 512 + c] = (half_t)ag[cc][tk];
            }
        }
    }
}
__global__ void __launch_bounds__(64) k_rwkv_scan(P p) {
    const int lane = threadIdx.x;
    for (int u = blockIdx.x; u < NB * 8; u += gridDim.x) {
        const int b = u >> 3, hh = u & 7, c = hh * 64 + lane;
        const float mur = p.b_mu[c], muk = p.b_mu[512 + c], muv = p.b_mu[1024 + c], kkw = p.b_k_k[c], kaw = p.b_k_a[c];
        float S[64];
#pragma unroll
        for (int k = 0; k < 64; ++k) S[k] = 0.f;
        float pr = 0.f, pk = 0.f, pv = 0.f;
        for (int t = 0; t < T; ++t) {
            const long row = (long)b * T + t;
            const float cr = (float)p.p[row * EVEN_IN + E_PB + c], ck = (float)p.p[row * EVEN_IN + E_PB + 512 + c], cv = (float)p.p[row * EVEN_IN + E_PB + 1024 + c];
            const float r = cr + (pr - cr) * mur, k0 = ck + (pk - ck) * muk, v = cv + (pv - cv) * muv;
            pr = cr; pk = ck; pv = cv;
            const float a = (float)p.rwA[row * 512 + c], w = expf(-(float)p.rwL[row * 512 + c]);
            float kk = k0 * kkw;
            const float nrm = fmaxf(sqrtf(wave_sum(kk * kk)), 1e-12f);
            kk = kk / nrm;
            const float k = k0 * (1.0f + (a - 1.0f) * kaw);
            const float ka = kk * a;
            float sk = 0.f;
#pragma unroll
            for (int j = 0; j < 64; ++j) sk += S[j] * bcast_lane(kk, j);
            float y = 0.f;
#pragma unroll
            for (int j = 0; j < 64; ++j) {
                S[j] = S[j] * bcast_lane(w, j) - sk * bcast_lane(ka, j) + v * bcast_lane(k, j);
                y += S[j] * bcast_lane(r, j);
            }
            p.rwY[row * 512 + c] = y;
        }
    }
}
__global__ void __launch_bounds__(256) k_rwkv_post(P p) {
    const int lane = threadIdx.x & 63, w = threadIdx.x >> 6;
    for (long u = (long)blockIdx.x * 4 + w; u < (long)M * 8; u += (long)gridDim.x * 4) {
        const long row = u >> 3; const int hh = (int)(u & 7), c = hh * 64 + lane, tt = (int)(row % T);
        const float y = p.rwY[row * 512 + c];
        const float mean = wave_sum(y) * (1.0f / 64.0f);
        const float dlt = y - mean;
        const float var = wave_sum(dlt * dlt) * (1.0f / 64.0f);
        const float yn = dlt * rsqrtf(var + 64e-5f) * p.b_ln_w[c] + p.b_ln_b[c];
        const float r = tshift(p.p, row, tt, c, p.b_mu[c]), k0 = tshift(p.p, row, tt, 512 + c, p.b_mu[512 + c]), v = tshift(p.p, row, tt, 1024 + c, p.b_mu[1024 + c]);
        const float a = (float)p.rwA[row * 512 + c];
        const float k = k0 * (1.0f + (a - 1.0f) * p.b_k_a[c]);
        const float bonus = wave_sum(r * k * p.b_r_k[c]) * v;
        p.y[row * D + 512 + c] = (half_t)((yn + bonus) * (float)p.rwG[row * 512 + c]);
    }
}

__global__ void __launch_bounds__(256) k_moba_kmean(P p) {
    const int total = NB * NBLK * 128;
    for (int i = blockIdx.x * 256 + threadIdx.x; i < total; i += gridDim.x * 256) {
        const int c = i & 127, blk = (i >> 7) % NBLK, b = i / (128 * NBLK);
        float s = 0.f;
        for (int r = 0; r < 256; ++r) s += (float)p.p[((long)b * T + blk * 256 + r) * ODD_PAD + O_KC + c];
        p.kmean[i] = s * (1.0f / 256.0f);
    }
}
__global__ void __launch_bounds__(256) k_moba_gate(P p) {
    for (long i = (long)blockIdx.x * 256 + threadIdx.x; i < (long)M * 2; i += (long)gridDim.x * 256) {
        const long row = i >> 1; const int kvh = (int)(i & 1), b = (int)(row / T), t = (int)(row % T), own = t >> 8;
        float best[3] = {-INFINITY, -INFINITY, -INFINITY}; int bi[3] = {-1, -1, -1};
        if (own > 0) {
            float qs[64];
#pragma unroll
            for (int d = 0; d < 64; ++d) qs[d] = 0.f;
            for (int g = 0; g < 4; ++g)
#pragma unroll
                for (int d8 = 0; d8 < 8; ++d8) { h8 v = *(const h8*)(p.p + row * ODD_PAD + O_QC + (kvh * 4 + g) * 64 + d8 * 8);
#pragma unroll
                    for (int j = 0; j < 8; ++j) qs[d8 * 8 + j] += (float)v[j]; }
            for (int n = 0; n < own; ++n) {
                const float* km = p.kmean + ((long)b * NBLK + n) * 128 + kvh * 64;
                float gsum = 0.f;
#pragma unroll
                for (int d = 0; d < 64; ++d) gsum += qs[d] * km[d];
                if (gsum > best[0]) { best[2] = best[1]; bi[2] = bi[1]; best[1] = best[0]; bi[1] = bi[0]; best[0] = gsum; bi[0] = n; }
                else if (gsum > best[1]) { best[2] = best[1]; bi[2] = bi[1]; best[1] = gsum; bi[1] = n; }
                else if (gsum > best[2]) { best[2] = gsum; bi[2] = n; }
            }
        }
        unsigned mk = 0;
#pragma unroll
        for (int s = 0; s < 3; ++s) if (bi[s] >= 0) mk |= 1u << bi[s];
        p.mmask[i] = (unsigned short)mk;
    }
}
__device__ void moba_wave(const P& p, int b, int t0, int hh) {
    const int lane = threadIdx.x & 63, lr = lane & 15, lg = lane >> 4, kvh = hh >> 2;
    const half_t* pp = p.p; const int ld = ODD_PAD;
    const int tq = t0 + lr, own = t0 >> 8;
    h8 qf[2];
#pragma unroll
    for (int c = 0; c < 2; ++c) qf[c] = *(const h8*)(pp + ((long)b * T + tq) * ld + O_QC + hh * 64 + c * 32 + lg * 8);
    const float* bd = p.bias_dist + hh * 4096;
    const unsigned mymask = p.mmask[((long)b * T + tq) * 2 + kvh];
    unsigned um = mymask;
    um |= __shfl_xor(um, 1); um |= __shfl_xor(um, 2); um |= __shfl_xor(um, 4); um |= __shfl_xor(um, 8);
    um = __shfl(um, 0);
    float m = -INFINITY, l = 0.f; f4 o[4];
#pragma unroll
    for (int i = 0; i < 4; ++i) o[i] = (f4){0.f, 0.f, 0.f, 0.f};
    for (int blk = 0; blk <= own; ++blk) {
        if (blk < own && !((um >> blk) & 1)) continue;
        const bool sel = (blk == own) || ((mymask >> blk) & 1);
        const int nst = (blk == own) ? ((t0 + 15 - own * 256) / 32 + 1) : 8;
        for (int st = 0; st < nst; ++st) {
            const int s0 = blk * 256 + st * 32;
            f4 sv[2];
#pragma unroll
            for (int tl = 0; tl < 2; ++tl) {
                const int key = s0 + tl * 16 + lr;
                f4 acc = (f4){0.f, 0.f, 0.f, 0.f};
#pragma unroll
                for (int c = 0; c < 2; ++c) { h8 kf = *(const h8*)(pp + ((long)b * T + key) * ld + O_KC + kvh * 64 + c * 32 + lg * 8); acc = mfma16(kf, qf[c], acc); }
#pragma unroll
                for (int r = 0; r < 4; ++r) { int ks = s0 + tl * 16 + 4 * lg + r, dist = tq - ks; bool ok = sel && dist >= 0; acc[r] = ok ? acc[r] * 0.125f + bd[dist] : -INFINITY; }
                sv[tl] = acc;
            }
            h8 vf[4];
#pragma unroll
            for (int dt = 0; dt < 4; ++dt) {
                const half_t* vr = p.vT + ((long)b * 128 + kvh * 64 + dt * 16 + lr) * T;
                h4 a = *(const h4*)(vr + s0 + 4 * lg), bb = *(const h4*)(vr + s0 + 16 + 4 * lg);
                vf[dt] = (h8){a[0], a[1], a[2], a[3], bb[0], bb[1], bb[2], bb[3]};
            }
            attn_step<4>(sv[0], sv[1], vf, m, l, o);
        }
    }
    l += __shfl_xor(l, 16); l += __shfl_xor(l, 32);
    const float inv = 1.0f / l;
#pragma unroll
    for (int dt = 0; dt < 4; ++dt) {
        h4 ov;
#pragma unroll
        for (int r = 0; r < 4; ++r) ov[r] = (half_t)(o[dt][r] * inv);
        *(h4*)(p.y + ((long)b * T + tq) * D + hh * 64 + dt * 16 + 4 * lg) = ov;
    }
}
__global__ void __launch_bounds__(256) k_moba(P p) {
    const int w = threadIdx.x >> 6, nt = T / 16, total = NB * nt * 8;
    for (int u = blockIdx.x * 4 + w; u < total; u += gridDim.x * 4) {
        int hh = u & 7, r = u >> 3; int tile = nt - 1 - (r % nt);
        moba_wave(p, r / nt, tile * 16, hh);
    }
}

__global__ void __launch_bounds__(256) k_dsa_kin(P p) {
    const int lane = threadIdx.x & 63, w = threadIdx.x >> 6;
    for (long row = (long)blockIdx.x * 4 + w; row < M; row += (long)gridDim.x * 4) {
        const float v = (float)p.p[row * ODD_PAD + O_KI + lane];
        const float ss = wave_sum(v * v);
        p.kin[row * 64 + lane] = (half_t)(v * rsqrtf(ss * (1.0f / 64.0f) + EPS) * p.d_kidx_norm[lane]);
    }
}
__device__ __forceinline__ unsigned fkey(float f) { unsigned u = __builtin_bit_cast(unsigned, f); return (u & 0x80000000u) ? ~u : (u | 0x80000000u); }
__device__ void dsa_select_wave(const float* sr, int t, unsigned short* out) {
    const int lane = threadIdx.x & 63;
    constexpr int NJ = T / 64;
    const int n = t + 1;
    if (n <= DSA_K) { for (int i = lane; i < n; i += 64) out[i] = (unsigned short)i; return; }
    unsigned u[NJ];
#pragma unroll
    for (int j = 0; j < NJ; ++j) { const int key = j * 64 + lane; u[j] = (key < n) ? fkey(sr[key]) : 0u; }
    unsigned thr = 0;
    for (int bit = 31; bit >= 0; --bit) {
        const unsigned cand = thr | (1u << bit);
        int c = 0;
#pragma unroll
        for (int j = 0; j < NJ; ++j) c += (u[j] >= cand) ? 1 : 0;
        c = (int)wave_sum((float)c);
        if (c >= DSA_K) thr = cand;
    }
    int cgt = 0;
#pragma unroll
    for (int j = 0; j < NJ; ++j) cgt += (u[j] > thr) ? 1 : 0;
    cgt = (int)wave_sum((float)cgt);
    const int need = DSA_K - cgt;
    int eqbase = 0, pos = 0;
    const unsigned long long lt = (lane == 0) ? 0ull : (~0ull >> (64 - lane));
#pragma unroll
    for (int j = 0; j < NJ; ++j) {
        const bool eq = (u[j] == thr);
        const unsigned long long beq = __ballot(eq);
        const int erank = eqbase + __popcll(beq & lt);
        const bool sel = (u[j] > thr) || (eq && erank < need);
        const unsigned long long bs = __ballot(sel);
        if (sel) out[pos + __popcll(bs & lt)] = (unsigned short)(j * 64 + lane);
        eqbase += __popcll(beq); pos += __popcll(bs);
    }
}
__global__ void __launch_bounds__(256) k_dsa_index(P p) {
    const int lane = threadIdx.x & 63, w = threadIdx.x >> 6, lr = lane & 15, lg = lane >> 4;
    const int nt = T / 16;
    float* scr = p.scores + (long)blockIdx.x * 16 * T;
    for (int u = blockIdx.x; u < NB * nt; u += gridDim.x) {
        const int b = u / nt, t0 = (nt - 1 - (u % nt)) * 16, tq = t0 + lr;
        const long row = (long)b * T + tq;
        h8 qf[4][2]; float wv[4];
#pragma unroll
        for (int ih = 0; ih < 4; ++ih) {
            wv[ih] = (float)p.p[row * ODD_PAD + O_WI + ih] * 0.0625f;
#pragma unroll
            for (int c = 0; c < 2; ++c) qf[ih][c] = *(const h8*)(p.p + row * ODD_PAD + O_QI + ih * 64 + c * 32 + lg * 8);
        }
        __syncthreads();
        for (int kt = w; kt * 16 < t0 + 16; kt += 4) {
            const int s0 = kt * 16;
            h8 kf[2];
#pragma unroll
            for (int c = 0; c < 2; ++c) kf[c] = *(const h8*)(p.kin + ((long)b * T + s0 + lr) * 64 + c * 32 + lg * 8);
            f4 sc = (f4){0.f, 0.f, 0.f, 0.f};
#pragma unroll
            for (int ih = 0; ih < 4; ++ih) {
                f4 acc = (f4){0.f, 0.f, 0.f, 0.f};
                acc = mfma16(kf[0], qf[ih][0], acc); acc = mfma16(kf[1], qf[ih][1], acc);
#pragma unroll
                for (int r = 0; r < 4; ++r) sc[r] += wv[ih] * fmaxf(acc[r], 0.f);
            }
            *(f4*)(scr + (long)lr * T + s0 + 4 * lg) = sc;
        }
        __threadfence();
        __syncthreads();
        for (int qi = w; qi < 16; qi += 4) dsa_select_wave(scr + (long)qi * T, t0 + qi, p.dsel + ((long)b * T + t0 + qi) * 256);
    }
}
__device__ void dsa_wave(const P& p, long row) {
    const int lane = threadIdx.x & 63, lr = lane & 15, lg = lane >> 4, hh = lr & 7;
    const int t = (int)(row % T); const long rb = row - t;
    const int cnt = (t + 1 < DSA_K) ? t + 1 : DSA_K;
    const unsigned short* sl = p.dsel + row * 256;
    const half_t* pp = p.p; const int ld = ODD_PAD;
    h8 qf[2];
#pragma unroll
    for (int c = 0; c < 2; ++c) qf[c] = *(const h8*)(pp + row * ld + O_QD + hh * 64 + c * 32 + lg * 8);
    const float* bd = p.bias_dist + hh * 4096;
    float m = -INFINITY, l = 0.f; f4 o[4];
#pragma unroll
    for (int i = 0; i < 4; ++i) o[i] = (f4){0.f, 0.f, 0.f, 0.f};
    for (int s0 = 0; s0 < cnt; s0 += 32) {
        f4 sv[2];
#pragma unroll
        for (int tl = 0; tl < 2; ++tl) {
            const int slot = s0 + tl * 16 + lr; const int key = slot < cnt ? sl[slot] : 0;
            f4 acc = (f4){0.f, 0.f, 0.f, 0.f};
#pragma unroll
            for (int c = 0; c < 2; ++c) { h8 kf = *(const h8*)(pp + (rb + key) * ld + O_KD + c * 32 + lg * 8); acc = mfma16(kf, qf[c], acc); }
#pragma unroll
            for (int r = 0; r < 4; ++r) { const int sl2 = s0 + tl * 16 + 4 * lg + r; const bool ok = sl2 < cnt; const int k2 = ok ? sl[sl2] : 0; acc[r] = ok ? acc[r] * 0.125f + bd[t - k2] : -INFINITY; }
            sv[tl] = acc;
        }
        int kj[8];
#pragma unroll
        for (int j = 0; j < 8; ++j) { const int slot = s0 + (j < 4 ? 4 * lg + j : 16 + 4 * lg + j - 4); kj[j] = slot < cnt ? sl[slot] : 0; }
        h8 vf[4];
#pragma unroll
        for (int dt = 0; dt < 4; ++dt)
#pragma unroll
            for (int j = 0; j < 8; ++j) vf[dt][j] = pp[(rb + kj[j]) * ld + O_VD + dt * 16 + lr];
        attn_step<4>(sv[0], sv[1], vf, m, l, o);
    }
    l += __shfl_xor(l, 16); l += __shfl_xor(l, 32);
    const float inv = 1.0f / l;
    if (lr < 8) {
#pragma unroll
        for (int dt = 0; dt < 4; ++dt) {
            h4 ov;
#pragma unroll
            for (int r = 0; r < 4; ++r) ov[r] = (half_t)(o[dt][r] * inv);
            *(h4*)(p.y + row * D + 512 + hh * 64 + dt * 16 + 4 * lg) = ov;
        }
    }
}
__global__ void __launch_bounds__(256) k_dsa(P p) {
    const int w = threadIdx.x >> 6;
    for (long row = (long)blockIdx.x * 4 + w; row < M; row += (long)gridDim.x * 4) dsa_wave(p, row);
}

}

#ifdef CPU_EMU
#define LAUNCH(kern, grid, block, ...) emu::launch(dim3(grid), dim3(block), [=] { kern(__VA_ARGS__); })
static P g_dbgP;
static void (*g_dbg_hook)(int, int) = nullptr;
#else
#define LAUNCH(kern, grid, block, ...) hipLaunchKernelGGL(kern, dim3(grid), dim3(block), 0, stream, __VA_ARGS__)
#endif

extern "C" void kernel_launch(void* const* d_in, const int* in_sizes, int n_in, void* d_out, int out_size, void* d_ws, size_t ws_size, hipStream_t stream) {
    (void)in_sizes; (void)n_in; (void)out_size; (void)ws_size;
    P p{};
    const float** ins = (const float**)&p;
    for (int i = 0; i < 26; ++i) ins[i] = (const float*)d_in[i];
    p.out = (float*)d_out;
    char* ws = (char*)d_ws; size_t off = 0;
    auto alloc = [&](size_t bytes) { void* r = ws + off; off += (bytes + 255) & ~(size_t)255; return r; };
    p.wt_ev = (half_t*)alloc((size_t)EVEN_IN * D * 2); p.wt_od = p.wt_ev;
    p.wt_mix = (half_t*)alloc((size_t)D * D * 2); p.wt_q = (half_t*)alloc((size_t)512 * D * 2);
    p.wt_kv = (half_t*)alloc((size_t)1024 * D * 2); p.wt_o = (half_t*)alloc((size_t)D * 512 * 2);
    p.wt_f1 = (half_t*)alloc((size_t)DFF * D * 2); p.wt_f2 = (half_t*)alloc((size_t)D * DFF * 2);
    p.memn = (half_t*)alloc((size_t)NB * MEM * D * 2); p.memkv = (half_t*)alloc((size_t)NB * MEM * 1024 * 2); p.memvT = (half_t*)alloc((size_t)NB * 512 * MEM * 2);
    p.vT = (half_t*)alloc((size_t)NB * 128 * T * 2); p.kin = (half_t*)alloc((size_t)M * 64 * 2);
    p.kmean = (float*)alloc((size_t)NB * NBLK * 128 * 4); p.bias_dist = (float*)alloc(8 * 4096 * 4);
    p.mmask = (unsigned short*)alloc((size_t)M * 2 * 2); p.dsel = (unsigned short*)alloc((size_t)M * 256 * 2);
    p.h = (half_t*)alloc((size_t)M * D * 2); p.o = p.h; p.rwY = (float*)p.h;
    char* big = (char*)alloc(0);
    const size_t szP0 = (size_t)M * EVEN_IN * 2, szP1 = (size_t)M * ODD_PAD * 2, szY = (size_t)M * D * 2, szC = (size_t)M * 512 * 2;
    const size_t szScr = (size_t)256 * 16 * T * 4;
    size_t bigsz = szP0 + szY + 3 * szC;
    if (szP1 + szY + szScr > bigsz) bigsz = szP1 + szY + szScr;
    if ((size_t)M * DFF * 2 > bigsz) bigsz = (size_t)M * DFF * 2;
    off += bigsz;
    if (off > ws_size) { fprintf(stderr, "workspace too small: need %zu have %zu\n", off, ws_size); }
    p.u = (half_t*)big; p.xq = (half_t*)big; p.xo = (half_t*)(big + szC);
#ifdef CPU_EMU
    g_dbgP = p;
#endif
    const int G = 1024;
    LAUNCH(k_bias_table, 128, 256, p.rel_bias, p.bias_dist);
    const float* xcur = p.x;
    LAUNCH(k_rmsnorm, G, 256, xcur, p.norm_gains + 0, p.h, M);
    for (int l = 0; l < 2; ++l) {
        const float* g = p.norm_gains + (size_t)l * 6 * D;
        if (l == 0) LAUNCH(k_transpose_w, G, 256, p.ev_w_in, D, EVEN_IN, p.wt_ev, EVEN_IN);
        else LAUNCH(k_transpose_w, G, 256, p.od_w_in, D, ODD_IN, p.wt_od, ODD_PAD);
        LAUNCH(k_transpose_w, G, 256, p.mix_w_out + (size_t)l * D * D, D, D, p.wt_mix, D);
        LAUNCH(k_transpose_w, G, 256, p.x_wq + (size_t)l * D * 512, D, 512, p.wt_q, 512);
        LAUNCH(k_transpose_w, G, 256, p.x_wkv + (size_t)l * D * 1024, D, 1024, p.wt_kv, 1024);
        LAUNCH(k_transpose_w, G, 256, p.x_wo + (size_t)l * 512 * D, 512, D, p.wt_o, D);
        LAUNCH(k_transpose_w, G, 256, p.ff_w1 + (size_t)l * D * DFF, D, DFF, p.wt_f1, DFF);
        LAUNCH(k_transpose_w, G, 256, p.ff_w2 + (size_t)l * DFF * D, DFF, D, p.wt_f2, D);
        LAUNCH(k_rmsnorm, G, 256, p.mem, p.mem_norm + l * D, p.memn, NB * MEM);
        LAUNCH(k_gemm<EPI_F16>, G, 256, p.memn, D, p.wt_kv, D, NB * MEM, 1024, D, (void*)p.memkv, 1024);
        LAUNCH(k_transpose_cols, G, 256, p.memkv, 1024, 512, 512, MEM, NB, p.memvT);
        if (l == 0) {
            p.p = (half_t*)big; p.y = (half_t*)(big + szP0); p.rwL = (half_t*)(big + szP0 + szY); p.rwA = p.rwL + (size_t)M * 512; p.rwG = p.rwA + (size_t)M * 512;
            LAUNCH(k_gemm<EPI_F16>, G, 256, p.h, D, p.wt_ev, D, M, EVEN_IN, D, (void*)p.p, EVEN_IN);
            LAUNCH(k_transpose_cols, G, 256, p.p, EVEN_IN, E_VA, 128, T, NB, p.vT);
            LAUNCH(k_swa, G, 256, p);
            LAUNCH(k_rwkv_prep, G, 256, p);
            LAUNCH(k_rwkv_scan, NB * 8, 64, p);
            LAUNCH(k_rwkv_post, G * 4, 256, p);
        } else {
            p.p = (half_t*)big; p.y = (half_t*)(big + szP1); p.scores = (float*)(big + szP1 + szY);
            LAUNCH(k_gemm<EPI_F16>, G, 256, p.h, D, p.wt_od, D, M, ODD_PAD, D, (void*)p.p, ODD_PAD);
            LAUNCH(k_transpose_cols, G, 256, p.p, ODD_PAD, O_VC, 128, T, NB, p.vT);
            LAUNCH(k_moba_kmean, 64, 256, p);
            LAUNCH(k_moba_gate, 128, 256, p);
            LAUNCH(k_moba, G, 256, p);
            LAUNCH(k_dsa_kin, G, 256, p);
            LAUNCH(k_dsa_index, 256, 256, p);
            LAUNCH(k_dsa, G, 256, p);
        }
#ifdef CPU_EMU
        g_dbgP = p;
        if (g_dbg_hook) g_dbg_hook(l, 0);
#endif
        LAUNCH(k_gemm<EPI_F16>, G, 256, p.y, D, p.wt_mix, D, M, D, D, (void*)p.o, D);
        LAUNCH(k_post, G, 256, xcur, p.o, g + 1 * D, g + 2 * D, p.out, p.h, M);
        xcur = p.out;
#ifdef CPU_EMU
        if (g_dbg_hook) g_dbg_hook(l, 1);
#endif
        LAUNCH(k_gemm<EPI_F16>, G, 256, p.h, D, p.wt_q, D, M, 512, D, (void*)p.xq, 512);
        LAUNCH(k_xattn, G, 256, p, l);
#ifdef CPU_EMU
        if (g_dbg_hook) g_dbg_hook(l, 2);
#endif
        LAUNCH(k_gemm<EPI_F16>, G, 256, p.xo, 512, p.wt_o, 512, M, D, 512, (void*)p.o, D);
        LAUNCH(k_post, G, 256, xcur, p.o, g + 3 * D, g + 4 * D, p.out, p.h, M);
#ifdef CPU_EMU
        if (g_dbg_hook) g_dbg_hook(l, 3);
#endif
        LAUNCH(k_gemm<EPI_RELU2>, G, 256, p.h, D, p.wt_f1, D, M, DFF, D, (void*)p.u, DFF);
        LAUNCH(k_gemm<EPI_F16>, G, 256, p.u, DFF, p.wt_f2, DFF, M, D, DFF, (void*)p.o, D);
        LAUNCH(k_post, G, 256, xcur, p.o, g + 5 * D, (l == 0) ? (p.norm_gains + 6 * D) : (const float*)nullptr, p.out, p.h, M);
#ifdef CPU_EMU
        if (g_dbg_hook) g_dbg_hook(l, 4);
#endif
    }
}
```

```cpp
#ifndef CPU_EMU
#include <hip/hip_runtime.h>
#include <hip/hip_cooperative_groups.h>
#endif
#include <stdint.h>
#include <math.h>
#include <stdio.h>

#ifndef SEQ_T
#define SEQ_T 4096
#endif
#ifndef BATCH_B
#define BATCH_B 4
#endif

namespace {
#ifndef CPU_EMU
#pragma clang attribute push(__attribute__((always_inline)), apply_to = function)
#endif
constexpr int T = SEQ_T, NB = BATCH_B, M = NB * T, D = 1024;
constexpr int EVEN_IN = 2560, ODD_IN = 1732, ODD_PAD = 1792, DFF = 4096, MEM = 256;
constexpr int DSA_K = (T / 4 < 256) ? T / 4 : 256;
constexpr int NBLK = T / 256;
constexpr float EPS = 1e-6f;
constexpr int NT = 512, NW = 8;
constexpr int O_QC = 0, O_KC = 512, O_VC = 640, O_QD = 768, O_KD = 1280, O_VD = 1344, O_QI = 1408, O_KI = 1664, O_WI = 1728;
constexpr int E_QA = 0, E_KA = 512, E_VA = 640, E_PB = 768;

typedef _Float16 half_t;
typedef _Float16 h8 __attribute__((ext_vector_type(8)));
typedef _Float16 h4 __attribute__((ext_vector_type(4)));
typedef float f4 __attribute__((ext_vector_type(4)));
typedef unsigned u4 __attribute__((ext_vector_type(4)));

__device__ __forceinline__ f4 mfma16(h8 a, h8 b, f4 c) {
#ifdef CPU_EMU
    return emu_mfma_16x16x32_f16(a, b, c);
#else
    return __builtin_amdgcn_mfma_f32_16x16x32_f16(a, b, c, 0, 0, 0);
#endif
}
__device__ __forceinline__ f4 mfma4f32(float a, float b, f4 c) {
#ifdef CPU_EMU
    return emu_mfma_16x16x4_f32(a, b, c);
#else
    return __builtin_amdgcn_mfma_f32_16x16x4f32(a, b, c, 0, 0, 0);
#endif
}
__device__ __forceinline__ float bcast_lane(float v, int lane) {
#ifdef CPU_EMU
    return __shfl(v, lane);
#else
    return __builtin_bit_cast(float, __builtin_amdgcn_readlane(__builtin_bit_cast(int, v), lane));
#endif
}
__device__ __forceinline__ float fast_exp(float x) { return __expf(x); }
constexpr float LOG2E = 1.4426950408889634f;
__device__ __forceinline__ float fast_exp2(float x) {
#ifdef CPU_EMU
    return exp2f(x);
#else
    return __builtin_amdgcn_exp2f(x);
#endif
}
__device__ __forceinline__ float quad_bcast(float v, int i) {
#ifdef CPU_EMU
    return __shfl(v, ((int)(threadIdx.x & 63) & ~3) + i);
#else
    const int x = __builtin_bit_cast(int, v);
    switch (i) {
    case 0: return __builtin_bit_cast(float, __builtin_amdgcn_mov_dpp(x, 0x00, 0xF, 0xF, true));
    case 1: return __builtin_bit_cast(float, __builtin_amdgcn_mov_dpp(x, 0x55, 0xF, 0xF, true));
    case 2: return __builtin_bit_cast(float, __builtin_amdgcn_mov_dpp(x, 0xAA, 0xF, 0xF, true));
    default: return __builtin_bit_cast(float, __builtin_amdgcn_mov_dpp(x, 0xFF, 0xF, 0xF, true));
    }
#endif
}
#ifdef CPU_EMU
__device__ __forceinline__ float qb_mul(float vec, int i, float x) { return quad_bcast(vec, i) * x; }
__device__ __forceinline__ void qb_fmac(float& acc, float vec, int i, float x) { acc += quad_bcast(vec, i) * x; }
#else
#define QB_CASE(I) case I: asm("v_mul_f32_dpp %0, %1, %2 quad_perm:[" #I "," #I "," #I "," #I "] row_mask:0xf bank_mask:0xf" : "=v"(d) : "v"(vec), "v"(x)); break;
__device__ __forceinline__ float qb_mul(float vec, int i, float x) { float d; switch (i) { QB_CASE(0) QB_CASE(1) QB_CASE(2) default: asm("v_mul_f32_dpp %0, %1, %2 quad_perm:[3,3,3,3] row_mask:0xf bank_mask:0xf" : "=v"(d) : "v"(vec), "v"(x)); } return d; }
#undef QB_CASE
#define QB_CASE(I) case I: asm("v_fmac_f32_dpp %0, %1, %2 quad_perm:[" #I "," #I "," #I "," #I "] row_mask:0xf bank_mask:0xf" : "+v"(acc) : "v"(vec), "v"(x)); break;
__device__ __forceinline__ void qb_fmac(float& acc, float vec, int i, float x) { switch (i) { QB_CASE(0) QB_CASE(1) QB_CASE(2) default: asm("v_fmac_f32_dpp %0, %1, %2 quad_perm:[3,3,3,3] row_mask:0xf bank_mask:0xf" : "+v"(acc) : "v"(vec), "v"(x)); } }
#undef QB_CASE
#endif
#ifdef CPU_EMU
#define PIN(x) (void)0
#else
#define PIN(x) asm volatile("" : "+v"(x))
#endif
#ifdef CPU_EMU
#define TIDX ((int)threadIdx.x)
__device__ __forceinline__ int opaque_s(int v) { return v; }
#else
__device__ __forceinline__ int opaque_tid() { int t = threadIdx.x; asm volatile("" : "+v"(t)); return t; }
__device__ __forceinline__ int opaque_s(int v) { asm volatile("" : "+s"(v)); return v; }
#define TIDX opaque_tid()
#endif
#ifdef CPU_EMU
#define SCHED_FENCE() (void)0
#define WAVE_SYNC() emu::wave_barrier([] {})
#else
#define SCHED_FENCE() __builtin_amdgcn_sched_barrier(0)
#define WAVE_SYNC() (void)0
#endif
#ifdef CPU_EMU
#define SHFL_XOR(v, m) __shfl_xor(v, m)
#define SHFL_IDX(v, l) __shfl(v, l)
#define SHFL_DOWN(v, d) __shfl_down(v, d)
#else
template <class TT> __device__ __forceinline__ TT shfl_idx_raw(TT v, int src) { static_assert(sizeof(TT) == 4, ""); return __builtin_bit_cast(TT, __builtin_amdgcn_ds_bpermute(src << 2, __builtin_bit_cast(int, v))); }
#define SHFL_XOR(v, m) shfl_idx_raw(v, (TIDX & 63) ^ (m))
#define SHFL_IDX(v, l) shfl_idx_raw(v, (l))
#define SHFL_DOWN(v, d) shfl_idx_raw(v, ((TIDX & 63) + (d)) > 63 ? (TIDX & 63) : (TIDX & 63) + (d))
#endif
__device__ __forceinline__ float rows4_max(float v) {
#ifdef CPU_EMU
    v = fmaxf(v, __shfl_xor(v, 16)); return fmaxf(v, __shfl_xor(v, 32));
#else
    float xa = v, xb = v;
    asm volatile("s_nop 1\n\tv_permlane16_swap_b32 %0, %1" : "+v"(xa), "+v"(xb));
    const float m1 = fmaxf(xa, xb);
    float ya = m1, yb = m1;
    asm volatile("s_nop 1\n\tv_permlane32_swap_b32 %0, %1" : "+v"(ya), "+v"(yb));
    return fmaxf(ya, yb);
#endif
}
__device__ __forceinline__ float rows4_sum(float v) {
#ifdef CPU_EMU
    v += __shfl_xor(v, 16); return v + __shfl_xor(v, 32);
#else
    float xa = v, xb = v;
    asm volatile("s_nop 1\n\tv_permlane16_swap_b32 %0, %1" : "+v"(xa), "+v"(xb));
    const float s1 = xa + xb;
    float ya = s1, yb = s1;
    asm volatile("s_nop 1\n\tv_permlane32_swap_b32 %0, %1" : "+v"(ya), "+v"(yb));
    return ya + yb;
#endif
}

struct P {
    const float *x, *mem, *rel_bias, *norm_gains, *mix_w_out, *mem_norm, *x_wq, *x_wkv, *x_wo, *ff_w1, *ff_w2, *ev_w_in, *a_sinks, *b_mu, *b_w0,
        *b_w2, *b_a0, *b_a2, *b_g2, *b_k_k, *b_k_a, *b_r_k, *b_ln_w, *b_ln_b, *od_w_in, *d_kidx_norm;
    float* out;
    half_t *wt_ev, *wt_od, *wt_mix, *wt_q, *wt_kv, *wt_o, *wt_f1, *wt_f2, *wt_w2, *wt_a2, *wt_g2;
    half_t *h, *o, *p, *y0, *y1, *u, *xq, *xo, *memn, *memkv, *vT, *memvT, *kin, *rwL, *rwA, *rwG;
    float *rwCS, *kmean, *scores, *bias_dist; half_t* kvd; half_t* rwMh;
    half_t* rwY16;
    unsigned short *mmask, *dsel;
    char* big;
    unsigned* bar;
    float *xs, *xs2;
};
constexpr size_t SZ_P0 = (size_t)M * EVEN_IN * 2, SZ_P1 = (size_t)M * ODD_PAD * 2, SZ_Y = (size_t)M * D * 2, SZ_C = (size_t)M * 512 * 2;
constexpr int VTS = T + 64;
constexpr int SCS = T + 32;
constexpr int DSA_SCR_BLOCKS = 256;
constexpr size_t SZ_SCR = (size_t)DSA_SCR_BLOCKS * 16 * SCS * 4;

__device__ void ph_transpose_w(int vb, int nvb, char* smem_, const float* __restrict__ W, int K, int N, half_t* __restrict__ Wt, int Npad, const float* __restrict__ gk = nullptr) {
    float (*tile)[65] = (float (*)[65])smem_;
    const int nk = K / 64, nn = Npad / 64, tid = TIDX;
    for (int t = vb; t < nk * nn; t += nvb) {
        const int k0 = (t % nk) * 64, n0 = (t / nk) * 64;
        __syncthreads();
        {
            const int r = tid >> 3, c = (tid & 7) * 8;
            f4 v0 = (f4){0.f, 0.f, 0.f, 0.f}, v1 = v0;
            if (n0 + c + 3 < N) v0 = *(const f4*)(W + (long)(k0 + r) * N + n0 + c);
            if (n0 + c + 7 < N) v1 = *(const f4*)(W + (long)(k0 + r) * N + n0 + c + 4);
            if (gk) { const float gg = gk[k0 + r]; v0 = v0 * gg; v1 = v1 * gg; }
#pragma unroll
            for (int j = 0; j < 4; ++j) { tile[r][c + j] = v0[j]; tile[r][c + 4 + j] = v1[j]; }
        }
        __syncthreads();
        {
            const int n = tid & 63, kc = (tid >> 6) * 8;
            h8 o;
#pragma unroll
            for (int j = 0; j < 8; ++j) o[j] = (half_t)tile[kc + j][n];
            *(h8*)(Wt + (long)(n0 + n) * K + k0 + kc) = o;
        }
    }
}

template <int KR>
__device__ void wave_transpose_w(int wv, int nwv, float* tile_, const float* __restrict__ W, int K, int N, half_t* __restrict__ Wt, const float* __restrict__ gk) {
    float (*tile)[65] = (float (*)[65])tile_;
    const int lane = TIDX & 63, nk = K / KR, nn = N / 64;
    for (int t = wv; t < nk * nn; t += nwv) {
        const int k0 = (t % nk) * KR, n0 = (t / nk) * 64;
        WAVE_SYNC();
#pragma unroll 4
        for (int it = 0; it < KR / 4; ++it) {
            const int r = it * 4 + (lane >> 4), c = (lane & 15) * 4;
            f4 v = *(const f4*)(W + (long)(k0 + r) * N + n0 + c);
            if (gk) v = v * gk[k0 + r];
            tile[r][c] = v[0]; tile[r][c + 1] = v[1]; tile[r][c + 2] = v[2]; tile[r][c + 3] = v[3];
        }
        WAVE_SYNC();
#pragma unroll 2
        for (int kc = 0; kc < KR / 8; ++kc) {
            h8 o;
#pragma unroll
            for (int j = 0; j < 8; ++j) o[j] = (half_t)tile[kc * 8 + j][lane];
            *(h8*)(Wt + (long)(n0 + lane) * K + k0 + kc * 8) = o;
        }
    }
}
__device__ __forceinline__ int rel_bucket(int n) {
    if (n < 16) return n < 0 ? 0 : n;
    const int thr[15] = {21, 27, 35, 46, 59, 77, 99, 128, 166, 216, 280, 363, 470, 609, 790};
    int b = 16;
#pragma unroll
    for (int i = 0; i < 15; ++i) b += (n >= thr[i]) ? 1 : 0;
    return b;
}
__device__ void ph_bias_table(int vb, int nvb, const float* __restrict__ rel_bias, float* __restrict__ bias_dist) {
    for (int i = vb * NT + TIDX; i < 8 * 4096; i += nvb * NT) {
        int hh = i >> 12, d = i & 4095;
        bias_dist[i] = rel_bias[rel_bucket(d) * 8 + hh];
    }
}

__device__ __forceinline__ float wave_sum(float v) {
#ifdef CPU_EMU
#pragma unroll
    for (int o = 32; o >= 1; o >>= 1) v += SHFL_XOR(v, o);
    return v;
#else
#define WS_DPP(ctrl, rmask) v += __builtin_bit_cast(float, __builtin_amdgcn_update_dpp(0, __builtin_bit_cast(int, v), ctrl, rmask, 0xF, false))
    WS_DPP(0xB1, 0xF); WS_DPP(0x4E, 0xF); WS_DPP(0x114, 0xF); WS_DPP(0x118, 0xF); WS_DPP(0x142, 0xA); WS_DPP(0x143, 0xC);
#undef WS_DPP
    return __builtin_bit_cast(float, __builtin_amdgcn_readlane(__builtin_bit_cast(int, v), 63));
#endif
}
__device__ __forceinline__ unsigned wave_prefix_sum(unsigned v) {
#ifdef CPU_EMU
    const int lane = (int)(threadIdx.x & 63);
#pragma unroll
    for (int o = 1; o < 64; o <<= 1) { const unsigned oth = __shfl_up(v, o); v += (lane >= o) ? oth : 0u; }
    return v;
#else
#define WP_DPP(ctrl, rmask) v += (unsigned)__builtin_amdgcn_update_dpp(0, (int)v, ctrl, rmask, 0xF, false)
    WP_DPP(0x111, 0xF); WP_DPP(0x112, 0xF); WP_DPP(0x114, 0xF); WP_DPP(0x118, 0xF); WP_DPP(0x142, 0xA); WP_DPP(0x143, 0xC);
#undef WP_DPP
    return v;
#endif
}
__device__ __forceinline__ unsigned bcast_u(unsigned v, int src) {
#ifdef CPU_EMU
    return __shfl(v, src);
#else
    return (unsigned)__builtin_amdgcn_readlane((int)v, __builtin_amdgcn_readfirstlane(src));
#endif
}
__device__ void ph_rmsnorm(int vb, int nvb, const float* __restrict__ x, const float* __restrict__ g, half_t* __restrict__ h, int rows, half_t* __restrict__ x16 = nullptr, float* __restrict__ xs2 = nullptr) {
    const int lane = TIDX & 63, w = TIDX >> 6;
    for (int r = vb * NW + w; r < rows; r += nvb * NW) {
        const float* xr = x + (long)r * D;
        f4 v[4]; float ss = 0.f;
#pragma unroll
        for (int i = 0; i < 4; ++i) { v[i] = *(const f4*)(xr + i * 256 + lane * 4); ss += v[i][0] * v[i][0] + v[i][1] * v[i][1] + v[i][2] * v[i][2] + v[i][3] * v[i][3]; }
        ss = wave_sum(ss);
        const float rs = rsqrtf(ss * (1.0f / D) + EPS);
        if (xs2 && lane < 4) xs2[(size_t)(r >> 8) * 1024 + lane * 256 + (r & 255)] = (lane == 0) ? ss : 0.f;
#pragma unroll
        for (int i = 0; i < 4; ++i) {
            f4 gg = *(const f4*)(g + i * 256 + lane * 4); h4 o;
#pragma unroll
            for (int j = 0; j < 4; ++j) o[j] = (half_t)(v[i][j] * rs * gg[j]);
            if (x16) { h4 xo;
#pragma unroll
                for (int j = 0; j < 4; ++j) xo[j] = (half_t)v[i][j];
                *(h4*)(x16 + (long)r * D + i * 256 + lane * 4) = xo; }
            else *(h4*)(h + (long)r * D + i * 256 + lane * 4) = o;
        }
    }
}
__device__ void ph_post(int vb, int nvb, const float* x, const half_t* o, const float* __restrict__ gpost, const float* __restrict__ gpre,
                                              float* xout, half_t* h, int rows) {
    const int lane = TIDX & 63, w = TIDX >> 6;
    for (int r = vb * NW + w; r < rows; r += nvb * NW) {
        const half_t* orow = o + (long)r * D; const float* xr = x + (long)r * D;
        f4 v[4]; float ss = 0.f;
#pragma unroll
        for (int i = 0; i < 4; ++i) { h4 t4 = *(const h4*)(orow + i * 256 + lane * 4); v[i] = (f4){(float)t4[0], (float)t4[1], (float)t4[2], (float)t4[3]}; ss += v[i][0] * v[i][0] + v[i][1] * v[i][1] + v[i][2] * v[i][2] + v[i][3] * v[i][3]; }
        ss = wave_sum(ss);
        const float rs = rsqrtf(ss * (1.0f / D) + EPS);
        float s2 = 0.f;
#pragma unroll
        for (int i = 0; i < 4; ++i) {
            f4 gg = *(const f4*)(gpost + i * 256 + lane * 4); f4 xv = *(const f4*)(xr + i * 256 + lane * 4);
#pragma unroll
            for (int j = 0; j < 4; ++j) { v[i][j] = xv[j] + v[i][j] * rs * gg[j]; s2 += v[i][j] * v[i][j]; }
            *(f4*)(xout + (long)r * D + i * 256 + lane * 4) = v[i];
        }
        if (gpre) {
            s2 = wave_sum(s2);
            const float r2 = rsqrtf(s2 * (1.0f / D) + EPS);
#pragma unroll
            for (int i = 0; i < 4; ++i) {
                f4 gg = *(const f4*)(gpre + i * 256 + lane * 4); h4 ov;
#pragma unroll
                for (int j = 0; j < 4; ++j) ov[j] = (half_t)(v[i][j] * r2 * gg[j]);
                *(h4*)(h + (long)r * D + i * 256 + lane * 4) = ov;
            }
        }
    }
}

constexpr int EPI_F16 = 0, EPI_RELU2 = 2;
struct GemmEpi {
    half_t* O; int ldc; int act; int fused;
    const float* xs2_in; const void* x_in; void* x_out; int xin16, xout16; const float* g_post; const float* g_pre; half_t* hx; float* xs; unsigned* cnt; float* xs2_out;
};
#ifdef CPU_EMU
__device__ void ph_gemm(const GemmEpi& ge, int vb, int nvb, char* smem_, const half_t* A, const half_t* Bt, int Mr, int N, int K, int lda, int nsplit) {
    (void)smem_; (void)nvb;
    if (vb != 0 || TIDX != 0) return;
    std::vector<float> Af((size_t)Mr * K), Bf((size_t)N * K), Cf((size_t)Mr * N);
    std::vector<float> Af2((size_t)Mr * K);
    for (int i = 0; i < Mr; ++i) for (int k = 0; k < K; ++k) { Af[(size_t)i * K + k] = (float)A[(size_t)i * lda + k]; if (nsplit > 0) Af2[(size_t)i * K + k] = (float)A[(size_t)i * lda + K + k]; }
    for (size_t i = 0; i < Bf.size(); ++i) Bf[i] = (float)Bt[i];
    for (int i0 = 0; i0 < Mr; i0 += 32) for (int j0 = 0; j0 < N; j0 += 32) {
        float acc[32][32] = {};
        for (int k0 = 0; k0 < K; k0 += 256)
            for (int i = 0; i < 32; ++i) for (int j = 0; j < 32; ++j) {
                const float* a = ((nsplit > 0 && j0 >= nsplit * 256) ? &Af2[(size_t)(i0 + i) * K + k0] : &Af[(size_t)(i0 + i) * K + k0]); const float* bq = &Bf[(size_t)(j0 + j) * K + k0];
                float sacc = 0.f; for (int k = 0; k < 256 && k0 + k < K; ++k) sacc += a[k] * bq[k];
                acc[i][j] += sacc;
            }
        for (int i = 0; i < 32; ++i) for (int j = 0; j < 32; ++j) Cf[(size_t)(i0 + i) * N + j0 + j] = acc[i][j];
    }
    for (int i = 0; i < Mr; ++i) {
        float* c = &Cf[(size_t)i * N];
        if (!ge.fused) {
            float rs = 1.f;
            if (ge.xs2_in) { const float* q = ge.xs2_in + (size_t)(i / 256) * 1024 + (i % 256); rs = rsqrtf(((q[0] + q[256]) + (q[512] + q[768])) * (1.0f / 1024.0f) + EPS); }
            for (int j = 0; j < N; ++j) { float t = c[j] * rs; if (ge.act == EPI_RELU2) { t = fmaxf(t, 0.f); t = t * t; } ge.O[(size_t)i * ge.ldc + j] = (half_t)t; }
        } else {
            float ss = 0.f; for (int j = 0; j < N; ++j) ss += c[j] * c[j];
            const float rs = rsqrtf(ss * (1.0f / 1024.0f) + EPS);
            float part[4] = {0.f, 0.f, 0.f, 0.f};
            for (int j = 0; j < N; ++j) { const float xi = (float)((const half_t*)ge.x_in)[(size_t)i * D + j]; float xn = xi + c[j] * rs * ge.g_post[j];
                if (ge.xout16) { const half_t hq = (half_t)xn; ((half_t*)ge.x_out)[(size_t)i * D + j] = hq; xn = (float)hq; } else ((float*)ge.x_out)[(size_t)i * D + j] = xn;
                part[j >> 8] += xn * xn; }
            if (ge.g_pre) for (int q = 0; q < 4; ++q) ge.xs2_out[((size_t)(i / 256) * 4 + q) * 256 + (i % 256)] = part[q];
        }
    }
}
#else
namespace pg8 {
#define PG8_LAS __attribute__((address_space(3)))
constexpr int BM = 256, BK = 64, HALF = 128, HTB = HALF * BK * 2, NXCD = 8, WGM = 8;
__device__ __forceinline__ int lds_byte(int r, int c) { const int st = (r >> 4) * 2 + (c >> 5), rr = r & 15, cc = c & 31, ob = rr * 64 + cc * 2; return st * 1024 + (ob ^ (((ob >> 9) & 1) << 5)); }
__device__ __forceinline__ void stage_rc(int b, int& R, int& C) { const int st = b / 1024, sb = b % 1024, swz = sb ^ (((sb >> 9) & 1) << 5); R = (st >> 1) * 16 + swz / 64; C = (st & 1) * 32 + (swz % 64) / 2; }
__device__ __forceinline__ int perm32(int rho) { const int n = rho >> 4, i = rho & 15; return 8 * (i >> 2) + 4 * n + (i & 3); }
struct Unit { int pm, pn; };
struct Gemm { const half_t* A; const half_t* Bt; int M, N, K; int lda; int nsplit; };
struct StaticOrder {
    int nM, nN, nwg, G, c;
    __device__ void init(int M_, int N_, int G_, int c_) { nM = M_ / BM; nN = N_ / BM; nwg = nM * nN; G = G_; c = c_; }
    __device__ bool next(int i, Unit& u) const {
        const long L = (long)i * G + c; if (L >= nwg) return false;
        int wgid = (int)L; { const int q = nwg / NXCD, r = nwg % NXCD, xcd = wgid % NXCD, off = wgid / NXCD; wgid = (xcd < r ? xcd * (q + 1) : r * (q + 1) + (xcd - r) * q) + off; }
        const int nig = WGM * nN, gid = wgid / nig, fm = gid * WGM, gsz = (nM - fm) < WGM ? (nM - fm) : WGM;
        u.pm = fm + ((wgid % nig) % gsz); u.pn = (wgid % nig) / gsz; return true;
    }
};
struct EpiH {
    half_t* O; int ldc; int ACT; int fused;
    const float* xs2_in;
    const void* x_in; void* x_out; int xin16, xout16; const float* g_post; const float* g_pre; half_t* hx; float* xs; unsigned* cnt; float* xs2_out;
    __device__ __forceinline__ void operator()(const f4 (&acc)[2][2][4][2], const Unit& u, int wr, int wc, int fr, int fq) const {
        const int row0 = u.pm * BM + wr * 64 + fr, col0 = u.pn * BM + wc * 32 + 8 * fq;
#pragma unroll
        for (int ai = 0; ai < 2; ++ai)
#pragma unroll
            for (int m = 0; m < 4; ++m) { half_t* rowp = O + (size_t)(row0 + ai * HALF + m * 16) * ldc + col0;
                float rs = 1.f;
                if (xs2_in) { const float* q = xs2_in + (size_t)u.pm * 1024 + (wr * 64 + fr + ai * HALF + m * 16); rs = rsqrtf(((q[0] + q[256]) + (q[512] + q[768])) * (1.0f / 1024.0f) + EPS); }
#pragma unroll
                for (int bj = 0; bj < 2; ++bj) { h8 o;
#pragma unroll
                    for (int n = 0; n < 2; ++n)
#pragma unroll
                        for (int r = 0; r < 4; ++r) { float t = acc[ai][bj][m][n][r] * rs; if (ACT == EPI_RELU2) { t = fmaxf(t, 0.f); t = t * t; } o[n * 4 + r] = (half_t)t; }
                    *(h8*)(rowp + bj * HALF) = o; } }
    }
    __device__ __forceinline__ void run_fused(const f4 (&acc)[2][2][4][2], const Unit& u, int wr, int wc, int fr, int fq, float* red, int tid) const {
#pragma unroll
        for (int ai = 0; ai < 2; ++ai)
#pragma unroll
            for (int m = 0; m < 4; ++m) {
                float sq = 0.f;
#pragma unroll
                for (int bj = 0; bj < 2; ++bj)
#pragma unroll
                    for (int n = 0; n < 2; ++n) { const f4 v = acc[ai][bj][m][n]; sq += (v[0] * v[0] + v[1] * v[1]) + (v[2] * v[2] + v[3] * v[3]); }
                sq = rows4_sum(sq);
                if (fq == 0) red[(ai * HALF + wr * 64 + m * 16 + fr) * 4 + wc] = sq;
            }
        __syncthreads();
        if (tid < 256) { const float tot = (red[tid * 4] + red[tid * 4 + 1]) + (red[tid * 4 + 2] + red[tid * 4 + 3]);
            __hip_atomic_store(xs + ((size_t)u.pm * 4 + u.pn) * 256 + tid, tot, __ATOMIC_RELAXED, __HIP_MEMORY_SCOPE_AGENT); }
        asm volatile("s_waitcnt vmcnt(0)" ::: "memory");
        __syncthreads();
        if (tid == 0) {
            (void)__hip_atomic_fetch_add(cnt + u.pm, 1u, __ATOMIC_RELAXED, __HIP_MEMORY_SCOPE_AGENT);
            unsigned spins = 0;
            while (__hip_atomic_load(cnt + u.pm, __ATOMIC_RELAXED, __HIP_MEMORY_SCOPE_AGENT) < 4u) { __builtin_amdgcn_s_sleep(2); if (++spins > (1u << 22)) break; }
            __builtin_amdgcn_fence(__ATOMIC_ACQUIRE, "agent");
            asm volatile("s_waitcnt vmcnt(0)" ::: "memory");
        }
        __syncthreads();
        float* rsl = red + 1024;
        if (tid < 256) { const float* q = xs + (size_t)u.pm * 1024 + tid;
            const float t0 = __hip_atomic_load(q, __ATOMIC_RELAXED, __HIP_MEMORY_SCOPE_AGENT), t1 = __hip_atomic_load(q + 256, __ATOMIC_RELAXED, __HIP_MEMORY_SCOPE_AGENT),
                        t2 = __hip_atomic_load(q + 512, __ATOMIC_RELAXED, __HIP_MEMORY_SCOPE_AGENT), t3 = __hip_atomic_load(q + 768, __ATOMIC_RELAXED, __HIP_MEMORY_SCOPE_AGENT);
            rsl[tid] = rsqrtf(((t0 + t1) + (t2 + t3)) * (1.0f / 1024.0f) + EPS); }
        __syncthreads();
        const int col0 = u.pn * BM + wc * 32 + 8 * fq;
#pragma unroll
        for (int ai = 0; ai < 2; ++ai)
#pragma unroll
            for (int m = 0; m < 4; ++m) {
                const int rl = ai * HALF + wr * 64 + m * 16 + fr; const size_t row = (size_t)u.pm * BM + rl;
                const float rs = rsl[rl];
                float s2 = 0.f;
#pragma unroll
                for (int bj = 0; bj < 2; ++bj) {
                    const int c = col0 + bj * HALF; h8 xo;
                    const h8 xv = *(const h8*)((const half_t*)x_in + row * D + c);
                    const f4 gp0 = *(const f4*)(g_post + c), gp1 = *(const f4*)(g_post + c + 4);
                    f4 xn0, xn1;
#pragma unroll
                    for (int r = 0; r < 4; ++r) { xn0[r] = (float)xv[r] + acc[ai][bj][m][0][r] * rs * gp0[r]; xn1[r] = (float)xv[4 + r] + acc[ai][bj][m][1][r] * rs * gp1[r]; }
                    if (xout16) {
#pragma unroll
                        for (int r = 0; r < 4; ++r) { xo[r] = (half_t)xn0[r]; xo[4 + r] = (half_t)xn1[r]; xn0[r] = (float)xo[r]; xn1[r] = (float)xo[4 + r]; }
                        *(h8*)((half_t*)x_out + row * D + c) = xo;
                    } else { *(f4*)((float*)x_out + row * D + c) = xn0; *(f4*)((float*)x_out + row * D + c + 4) = xn1; }
#pragma unroll
                    for (int r = 0; r < 4; ++r) s2 += xn0[r] * xn0[r] + xn1[r] * xn1[r];
                }
                s2 = rows4_sum(s2);
                if (fq == 0) red[rl * 4 + wc] = s2;
            }
        __syncthreads();
        if (g_pre && tid < 256) xs2_out[((size_t)u.pm * 4 + u.pn) * 256 + tid] = (red[tid * 4] + red[tid * 4 + 1]) + (red[tid * 4 + 2] + red[tid * 4 + 3]);
    }
};
template <class Epi>
__device__ __forceinline__ void gemm_phase(PG8_LAS unsigned char* lds, const Gemm g, const StaticOrder& S, const Epi& E) {
    const int tid = TIDX, wid = __builtin_amdgcn_readfirstlane(tid >> 6), lane = tid & 63, wr = wid >> 2, wc = wid & 3, fr = lane & 15, fq = lane >> 4;
    const int K = g.K, nt = K / BK, lda = g.lda;
    unsigned voffA[2], voffB[2];
#pragma unroll
    for (int i = 0; i < 2; ++i) { int R, C; stage_rc(tid * 16 + i * 8192, R, C); const int Rb = (R & ~31) + perm32(R & 31);
        voffA[i] = (unsigned)(R * lda + C) * 2u; voffB[i] = (unsigned)(Rb * K + C) * 2u; }
    const size_t kstep = (size_t)(BK * 2);
    const size_t hstepA = (size_t)HALF * lda * 2, hstepB = (size_t)HALF * K * 2;
    const size_t tstepA = 2 * hstepA, tstepB = 2 * hstepB, ksplit = (size_t)K * 2;
    const int nsplit = g.nsplit > 0 ? g.nsplit : 0x7fffffff;
    const unsigned ldsw = (unsigned)wid * 1024u;
    const int aoff = lds_byte(wr * 64 + fr, fq * 8), boff = lds_byte(wc * 32 + fr, fq * 8);
#define PG8_SA(b, h) (((b) * 2 + (h)) * HTB)
#define PG8_SB(b, h) ((4 + (b) * 2 + (h)) * HTB)
#define PG8_STAGE(bufoff, gbase, voff) do { _Pragma("unroll") for (int _i = 0; _i < 2; ++_i) \
        __builtin_amdgcn_global_load_lds((const unsigned*)((const char*)(gbase) + (voff)[_i]), (PG8_LAS unsigned*)(lds + (bufoff) + ldsw + _i * 8192), 16, 0, 0); } while (0)
#define PG8_LDA(dst, b, h) do { _Pragma("unroll") for (int m = 0; m < 4; ++m) _Pragma("unroll") for (int k = 0; k < 2; ++k) dst[m][k] = *(const PG8_LAS h8*)(lds + PG8_SA(b, h) + aoff + m * 2048 + k * 1024); } while (0)
#define PG8_LDB(dst, b, h) do { _Pragma("unroll") for (int n = 0; n < 2; ++n) _Pragma("unroll") for (int k = 0; k < 2; ++k) dst[n][k] = *(const PG8_LAS h8*)(lds + PG8_SB(b, h) + boff + n * 2048 + k * 1024); } while (0)
#define PG8_MMA(ai, bj, At, Bt) do { __builtin_amdgcn_s_setprio(1); _Pragma("unroll") for (int m = 0; m < 4; ++m) _Pragma("unroll") for (int n = 0; n < 2; ++n) _Pragma("unroll") for (int k = 0; k < 2; ++k) \
        acc[ai][bj][m][n] = __builtin_amdgcn_mfma_f32_16x16x32_f16(Bt[n][k], At[m][k], acc[ai][bj][m][n], 0, 0, 0); __builtin_amdgcn_s_setprio(0); } while (0)
#define PG8_WAIT_V(n) asm volatile("s_waitcnt vmcnt(" #n ")" ::: "memory")
#define PG8_WAIT_L(n) asm volatile("s_waitcnt lgkmcnt(" #n ")" ::: "memory")
#define PG8_BAR __builtin_amdgcn_s_barrier()
#define PG8_SCHED __builtin_amdgcn_sched_barrier(0)
    Unit cur, nxt; int ui = 0;
    if (!S.next(0, cur)) return;
    f4 acc[2][2][4][2];
#pragma unroll
    for (int a = 0; a < 2; ++a)
#pragma unroll
        for (int b = 0; b < 2; ++b)
#pragma unroll
            for (int m = 0; m < 4; ++m)
#pragma unroll
                for (int n = 0; n < 2; ++n) acc[a][b][m][n] = (f4){0.f, 0.f, 0.f, 0.f};
    h8 At[4][2], B0[2][2], B1[2][2];
    const char* cA = (const char*)g.A + (size_t)cur.pm * tstepA + (cur.pn >= nsplit ? ksplit : 0); const char* cB = (const char*)g.Bt + (size_t)cur.pn * tstepB;
    PG8_STAGE(PG8_SB(0, 0), cB, voffB); PG8_STAGE(PG8_SB(0, 1), cB + hstepB, voffB); PG8_STAGE(PG8_SA(0, 0), cA, voffA); PG8_STAGE(PG8_SA(0, 1), cA + hstepA, voffA);
    if (wr == 1) PG8_BAR;
    PG8_WAIT_V(2); PG8_BAR;
    PG8_STAGE(PG8_SB(1, 0), cB + kstep, voffB); PG8_STAGE(PG8_SA(1, 0), cA + kstep, voffA); PG8_STAGE(PG8_SB(1, 1), cB + hstepB + kstep, voffB);
    PG8_WAIT_V(6); PG8_BAR;
    for (;;) {
        const bool has_next = S.next(ui + 1, nxt);
        const char* nA = has_next ? (const char*)g.A + (size_t)nxt.pm * tstepA + (nxt.pn >= nsplit ? ksplit : 0) : cA; const char* nB = has_next ? (const char*)g.Bt + (size_t)nxt.pn * tstepB : cB;
        for (int t = 0; t < nt; t += 2) {
            const bool last = (t == nt - 2);
            const char* a1 = cA + (size_t)(t + 1) * kstep;
            const char* a2 = last ? nA : cA + (size_t)(t + 2) * kstep; const char* b2 = last ? nB : cB + (size_t)(t + 2) * kstep;
            const char* a3 = a2 + kstep; const char* b3 = b2 + kstep;
            PG8_LDB(B0, 0, 0); PG8_LDB(B1, 0, 1); PG8_SCHED; PG8_LDA(At, 0, 0); PG8_STAGE(PG8_SA(1, 1), a1 + hstepA, voffA);
            PG8_WAIT_V(8); PG8_WAIT_L(0); PG8_BAR; PG8_MMA(0, 0, At, B0); PG8_MMA(0, 1, At, B1); PG8_BAR; PG8_SCHED;
            PG8_LDA(At, 0, 1); PG8_STAGE(PG8_SB(0, 0), b2, voffB); PG8_STAGE(PG8_SB(0, 1), b2 + hstepB, voffB); PG8_STAGE(PG8_SA(0, 0), a2, voffA);
            PG8_WAIT_V(8); PG8_WAIT_L(0); PG8_BAR; PG8_MMA(1, 0, At, B0); PG8_MMA(1, 1, At, B1); PG8_BAR; PG8_SCHED;
            PG8_LDB(B0, 1, 0); PG8_LDB(B1, 1, 1); PG8_SCHED; PG8_LDA(At, 1, 0); PG8_STAGE(PG8_SA(0, 1), a2 + hstepA, voffA);
            PG8_WAIT_V(8); PG8_WAIT_L(0); PG8_BAR; PG8_MMA(0, 0, At, B0); PG8_MMA(0, 1, At, B1); PG8_BAR; PG8_SCHED;
            PG8_LDA(At, 1, 1); PG8_STAGE(PG8_SB(1, 0), b3, voffB); PG8_STAGE(PG8_SB(1, 1), b3 + hstepB, voffB); PG8_STAGE(PG8_SA(1, 0), a3, voffA);
            PG8_WAIT_V(8); PG8_WAIT_L(0); PG8_BAR; PG8_MMA(1, 0, At, B0); PG8_MMA(1, 1, At, B1); PG8_BAR; PG8_SCHED;
        }
        if (wr == 0) PG8_BAR;
        if (!E.fused) E(acc, cur, wr, wc, fr, fq);
        if (!has_next) break;
#pragma unroll
        for (int a = 0; a < 2; ++a)
#pragma unroll
            for (int b = 0; b < 2; ++b)
#pragma unroll
                for (int m = 0; m < 4; ++m)
#pragma unroll
                    for (int n = 0; n < 2; ++n) acc[a][b][m][n] = (f4){0.f, 0.f, 0.f, 0.f};
        cur = nxt; cA = nA; cB = nB; ++ui;
        if (wr == 1) PG8_BAR;
    }
    PG8_WAIT_V(0);
    PG8_BAR;
    if (E.fused) E.run_fused(acc, cur, wr, wc, fr, fq, (float*)(unsigned char*)lds, tid);
#undef PG8_SA
#undef PG8_SB
#undef PG8_STAGE
#undef PG8_LDA
#undef PG8_LDB
#undef PG8_MMA
#undef PG8_WAIT_V
#undef PG8_WAIT_L
#undef PG8_BAR
#undef PG8_SCHED
}
}
__device__ __forceinline__ void ph_gemm(const GemmEpi& ge, int vb, int nvb, char* smem_, const half_t* A, const half_t* Bt, int Mr, int N, int K, int lda, int nsplit) {
    pg8::Gemm g{A, Bt, Mr, N, K, lda, nsplit}; pg8::StaticOrder S; S.init(Mr, N, nvb, vb);
    pg8::EpiH E{ge.O, ge.ldc, ge.act, ge.fused, ge.xs2_in, ge.x_in, ge.x_out, ge.xin16, ge.xout16, ge.g_post, ge.g_pre, ge.hx, ge.xs, ge.cnt, ge.xs2_out};
    __syncthreads();
    pg8::gemm_phase((__attribute__((address_space(3))) unsigned char*)smem_, g, S, E);
    __syncthreads();
}
#endif

__device__ void ph_transpose_cols(int vb, int nvb, char* smem_, const half_t* __restrict__ src, int ld, int c0, int nc, int tt, int nb, half_t* __restrict__ dst, int dld) {
    half_t (*tile)[66] = (half_t (*)[66])smem_;
    const int ntt = tt / 64, ncc = nc / 64, total = nb * ntt * ncc;
    for (int t = vb; t < total; t += nvb) {
        const int b = t / (ntt * ncc), r = t % (ntt * ncc), t0 = (r / ncc) * 64, cc0 = (r % ncc) * 64;
        __syncthreads();
        for (int i = TIDX; i < 4096; i += NT) { int rr = i >> 6, c = i & 63; tile[rr][c] = src[((long)b * tt + t0 + rr) * ld + c0 + cc0 + c]; }
        __syncthreads();
        for (int i = TIDX; i < 4096; i += NT) { int c = i >> 6, rr = i & 63; dst[((long)b * nc + cc0 + c) * dld + t0 + rr] = tile[rr][c]; }
    }
}

template <int DT>
__device__ __forceinline__ void attn_step(f4 s0, f4 s1, const h8 (&vf)[DT], float& m, float& l, f4 (&o)[DT]) {
    float mx = fmaxf(fmaxf(fmaxf(s0[0], s0[1]), fmaxf(s0[2], s0[3])), fmaxf(fmaxf(s1[0], s1[1]), fmaxf(s1[2], s1[3])));
    mx = rows4_max(mx);
    const float mn = fmaxf(m, mx);
    const float ms = (mn == -INFINITY) ? 0.f : mn;
    if (__ballot(mn > m)) {
        const float alpha = fast_exp2(m - ms);
        l = l * alpha;
#pragma unroll
        for (int dt = 0; dt < DT; ++dt) o[dt] = o[dt] * alpha;
    }
    h8 pb; float ps = 0.f;
#pragma unroll
    for (int r = 0; r < 4; ++r) { float p0 = fast_exp2(s0[r] - ms), p1 = fast_exp2(s1[r] - ms); ps += p0 + p1; pb[r] = (half_t)p0; pb[4 + r] = (half_t)p1; }
    l += ps;
#pragma unroll
    for (int dt = 0; dt < DT; ++dt) o[dt] = mfma16(vf[dt], pb, o[dt]);
    m = mn;
}
template <int DT>
__device__ __forceinline__ void attn_step64(const f4 (&sv)[4], const h8 (&vf0)[DT], const h8 (&vf1)[DT], float& m, float& l, f4 (&o)[DT], bool sel = true) {
    float mx = fmaxf(fmaxf(fmaxf(sv[0][0], sv[0][1]), fmaxf(sv[0][2], sv[0][3])), fmaxf(fmaxf(sv[1][0], sv[1][1]), fmaxf(sv[1][2], sv[1][3])));
    mx = fmaxf(mx, fmaxf(fmaxf(fmaxf(sv[2][0], sv[2][1]), fmaxf(sv[2][2], sv[2][3])), fmaxf(fmaxf(sv[3][0], sv[3][1]), fmaxf(sv[3][2], sv[3][3]))));
    mx = sel ? mx : -INFINITY;
    mx = rows4_max(mx);
    const float mn = fmaxf(m, mx);
    const float ms0 = (mn == -INFINITY) ? 0.f : mn;
    if (__ballot(mn > m)) {
        const float alpha = fast_exp2(m - ms0);
        l = l * alpha;
#pragma unroll
        for (int dt = 0; dt < DT; ++dt) o[dt] = o[dt] * alpha;
    }
    const float ms = sel ? ms0 : INFINITY;
    h8 pb0, pb1; float ps = 0.f;
#pragma unroll
    for (int r = 0; r < 4; ++r) {
        const float p0 = fast_exp2(sv[0][r] - ms), p1 = fast_exp2(sv[1][r] - ms), p2 = fast_exp2(sv[2][r] - ms), p3 = fast_exp2(sv[3][r] - ms);
        ps += (p0 + p1) + (p2 + p3); pb0[r] = (half_t)p0; pb0[4 + r] = (half_t)p1; pb1[r] = (half_t)p2; pb1[4 + r] = (half_t)p3;
    }
    l += ps;
#pragma unroll
    for (int dt = 0; dt < DT; ++dt) { o[dt] = mfma16(vf0[dt], pb0, o[dt]); o[dt] = mfma16(vf1[dt], pb1, o[dt]); }
    m = mn;
}
template <int KC, int DT> struct StepRegs { h8 kf[2][KC]; h8 vf[DT]; float bv[8]; int s0; int aux; };
template <int KC, int DT, class MASK>
__device__ __forceinline__ void attn_compute(const h8 (&qf)[KC], StepRegs<KC, DT>& cur, float& m, float& l, f4 (&o)[DT], MASK&& mask) {
    f4 sv[2];
#pragma unroll
    for (int tl = 0; tl < 2; ++tl) {
        f4 acc = (f4){0.f, 0.f, 0.f, 0.f};
#pragma unroll
        for (int c = 0; c < KC; ++c) acc = mfma16(cur.kf[tl][c], qf[c], acc);
        sv[tl] = acc;
    }
    mask(cur, sv[0], sv[1]);
    attn_step<DT>(sv[0], sv[1], cur.vf, m, l, o);
}
template <int KC, int DT, class NEXT, class LOAD, class MASK>
__device__ __forceinline__ void attn_loop(const h8 (&qf)[KC], float& m, float& l, f4 (&o)[DT], NEXT&& next, LOAD&& load, MASK&& mask) {
    StepRegs<KC, DT> A, B;
    A.s0 = 0; A.aux = 0;
    if (!next(A)) return;
    load(A);
    for (;;) {
        B.s0 = A.s0; B.aux = A.aux;
        bool hn = next(B);
        load(B);
        SCHED_FENCE();
        attn_compute<KC, DT>(qf, A, m, l, o, mask);
        if (!hn) break;
        A.s0 = B.s0; A.aux = B.aux;
        hn = next(A);
        load(A);
        SCHED_FENCE();
        attn_compute<KC, DT>(qf, B, m, l, o, mask);
        if (!hn) break;
    }
}
__device__ __forceinline__ h8 ld_vt8(const half_t* vr, int k0, int k1) {
    const h4 a = *(const h4*)(vr + k0), bb = *(const h4*)(vr + k1);
    return (h8){a[0], a[1], a[2], a[3], bb[0], bb[1], bb[2], bb[3]};
}

__device__ __forceinline__ h4 lds_tr_read(const half_t* addr) {
#ifdef CPU_EMU
    return emu_ds_read_tr16(addr);
#else
    typedef short v4i16 __attribute__((ext_vector_type(4)));
    const v4i16 r = __builtin_amdgcn_ds_read_tr16_b64_v4i16((__attribute__((address_space(3))) v4i16*)addr);
    return __builtin_bit_cast(h4, r);
#endif
}
template <int DH, int TK = 64> struct ATile {
    static constexpr int KC = DH / 32, DT = DH / 16, KS = DH + 8, VS = DH + 8, KB = TK * KS * 2, VB = TK * VS * 2, BUF = KB + VB;
    static constexpr int NKL = TK * (DH / 8) / NT, NVL = NKL;
    h8 kr[NKL], vr[NVL];
};
template <int DH, bool DBUF, int TK, class NEXT, class KSRC, class VSRC, class MASK, class SKIP>
__device__ __forceinline__ void attn_block(char* smem, const h8 (&qf)[DH / 32], float& m, float& l, f4 (&o)[DH / 16], NEXT&& next, KSRC&& ksrc, VSRC&& vsrc, MASK&& mask, SKIP&& skip) {
    typedef ATile<DH, TK> TL;
    const int tid = TIDX, lane = tid & 63, lr = lane & 15, lg = lane >> 4;
    TL R;
    auto issue = [&](int s0) {
#pragma unroll
        for (int i = 0; i < TL::NKL; ++i) { const int q = tid + i * NT, row = q / (DH / 8), ch = q % (DH / 8); R.kr[i] = *(const h8*)ksrc(s0, row, ch); }
#pragma unroll
        for (int i = 0; i < TL::NVL; ++i) { const int q = tid + i * NT, row = q / (DH / 8), ch = q % (DH / 8); R.vr[i] = *(const h8*)vsrc(s0, row, ch); }
    };
    auto stash = [&](char* buf) {
        half_t* K = (half_t*)buf; half_t* V = (half_t*)(buf + TL::KB);
#pragma unroll
        for (int i = 0; i < TL::NKL; ++i) { const int q = tid + i * NT, row = q / (DH / 8), ch = q % (DH / 8); *(h8*)(K + row * TL::KS + ch * 8) = R.kr[i]; }
#pragma unroll
        for (int i = 0; i < TL::NVL; ++i) { const int q = tid + i * NT, row = q / (DH / 8), ch = q % (DH / 8); *(h8*)(V + row * TL::VS + ch * 8) = R.vr[i]; }
    };
    auto compute = [&](const char* buf, int s0t) {
#pragma unroll 1
      for (int sub = 0; sub < TK / 64; ++sub) {
        const int s0 = s0t + sub * 64;
        if (skip(s0)) continue;
        const half_t* K = (const half_t*)buf + sub * 64 * TL::KS; const half_t* V = (const half_t*)(buf + TL::KB) + sub * 64 * TL::VS;
        f4 sv[4];
#pragma unroll
        for (int kt = 0; kt < 4; ++kt) {
            f4 acc = (f4){0.f, 0.f, 0.f, 0.f};
#pragma unroll
            for (int c = 0; c < TL::KC; ++c) acc = mfma16(*(const h8*)(K + (kt * 16 + lr) * TL::KS + c * 32 + lg * 8), qf[c], acc);
            sv[kt] = acc;
        }
        const bool qsel = mask(s0, sv);
        if (DH == 64) {
            h8 vf0[TL::DT], vf1[TL::DT];
#pragma unroll
            for (int dt = 0; dt < TL::DT; ++dt) {
                const half_t* vrow = V + (4 * lg + (lr >> 2)) * TL::VS + dt * 16 + 4 * (lr & 3);
                const h4 x0 = lds_tr_read(vrow), y0 = lds_tr_read(vrow + 16 * TL::VS), x1 = lds_tr_read(vrow + 32 * TL::VS), y1 = lds_tr_read(vrow + 48 * TL::VS);
                vf0[dt] = (h8){x0[0], x0[1], x0[2], x0[3], y0[0], y0[1], y0[2], y0[3]};
                vf1[dt] = (h8){x1[0], x1[1], x1[2], x1[3], y1[0], y1[1], y1[2], y1[3]};
            }
            attn_step64<TL::DT>(sv, vf0, vf1, m, l, o, qsel);
        } else {
#pragma unroll
            for (int hs = 0; hs < 2; ++hs) {
                h8 vf[TL::DT];
#pragma unroll
                for (int dt = 0; dt < TL::DT; ++dt) {
                    const half_t* vrow = V + (hs * 32 + 4 * lg + (lr >> 2)) * TL::VS + dt * 16 + 4 * (lr & 3);
                    const h4 x = lds_tr_read(vrow), y = lds_tr_read(vrow + 16 * TL::VS);
                    vf[dt] = (h8){x[0], x[1], x[2], x[3], y[0], y[1], y[2], y[3]};
                }
                attn_step<TL::DT>(sv[hs * 2], sv[hs * 2 + 1], vf, m, l, o);
            }
        }
      }
    };
    int s0 = 0, s1 = 0;
    __syncthreads();
    if (!next(s0)) return;
    issue(s0);
    if (DBUF) {
        stash(smem); __syncthreads();
        int cur = 0;
        for (;;) {
            const bool has = next(s1);
            if (has) issue(s1);
            compute(smem + cur * TL::BUF, s0);
            if (!has) break;
            stash(smem + (cur ^ 1) * TL::BUF);
            __syncthreads();
            cur ^= 1; s0 = s1;
        }
    } else {
        for (;;) {
            stash(smem); __syncthreads();
            const bool has = next(s1);
            if (has) issue(s1);
            compute(smem, s0);
            if (!has) break;
            __syncthreads();
            s0 = s1;
        }
    }
}
__device__ __forceinline__ int snake_unit(int i, int vb, int nvb) { return i * nvb + ((i & 1) ? nvb - 1 - vb : vb); }
constexpr int ATT_BUF64 = 2 * ATile<64>::BUF;

__device__ void ph_swa(int vb, int nvb, char* smem, const P& p) {
    const int tid = TIDX, w = tid >> 6, lane = tid & 63, lr = lane & 15, lg = lane >> 4, hd = w & 3, qt = w >> 2;
    const half_t* pp = p.p; const int ld = EVEN_IN;
    float* bt = (float*)(smem + ATT_BUF64) + w * 128;
    const int nunits = NB * 2 * (T / 32);
    int lastkv = -1;
    for (int i = 0;; ++i) {
        const int u = snake_unit(i, vb, nvb);
        if (u >= nunits) break;
        const int kvh = u & 1, b = (u >> 1) % NB, t0g = ((u >> 1) / NB) * 32, t0 = t0g + qt * 16, hh = kvh * 4 + hd, tq = t0 + lr;
        if (kvh != lastkv) { WAVE_SYNC(); for (int j = lane; j < 128; j += 64) bt[j] = p.bias_dist[hh * 4096 + j] * LOG2E; lastkv = kvh; WAVE_SYNC(); }
        h8 qf[2];
#pragma unroll
        for (int c = 0; c < 2; ++c) qf[c] = *(const h8*)(pp + ((long)b * T + tq) * ld + E_QA + hh * 64 + c * 32 + lg * 8);
        float m = -INFINITY, l = 0.f; f4 o[4];
#pragma unroll
        for (int q = 0; q < 4; ++q) o[q] = (f4){0.f, 0.f, 0.f, 0.f};
        int nx = (t0g - 127 < 0 ? 0 : t0g - 127) & ~63;
        attn_block<64, true, 64>(smem, qf, m, l, o,
            [&](int& s0) { if (nx > t0g + 31) return false; s0 = nx; nx += 64; return true; },
            [&](int s0, int row, int ch) { return pp + ((long)b * T + s0 + row) * ld + E_KA + kvh * 64 + ch * 8; },
            [&](int s0, int row, int ch) { return pp + ((long)b * T + s0 + row) * ld + E_VA + kvh * 64 + ch * 8; },
            [&](int s0, f4 (&a)[4]) {
#pragma unroll
                for (int kt = 0; kt < 4; ++kt)
#pragma unroll
                    for (int q = 0; q < 4; ++q) {
                        const int d0 = tq - (s0 + kt * 16 + 4 * lg + q);
                        const float b0 = bt[d0 & 127];
                        a[kt][q] = (d0 >= 0 && d0 < 128) ? a[kt][q] * (0.125f * LOG2E) + b0 : -INFINITY;
                    }
                return true;
            },
            [&](int s0) { return s0 > t0 + 15 || s0 + 63 < t0 - 127; });
        l = rows4_sum(l);
        const float sink = p.a_sinks[hh] * LOG2E;
        const float mf = fmaxf(m, sink), sc = fast_exp2(m - mf), inv = sc / (l * sc + fast_exp2(sink - mf));
#pragma unroll
        for (int dt = 0; dt < 4; ++dt) {
            h4 ov;
#pragma unroll
            for (int r = 0; r < 4; ++r) ov[r] = (half_t)(o[dt][r] * inv);
            *(h4*)(p.y0 + ((long)b * T + tq) * D + hh * 64 + dt * 16 + 4 * lg) = ov;
        }
    }
}

__device__ void ph_xattn(int vb, int nvb, char* smem, const P& p) {
    const int tid = TIDX, w = tid >> 6, lane = tid & 63, lr = lane & 15, lg = lane >> 4;
    const int nunits = NB * 4 * (T / 128);
    for (int u = vb; u < nunits; u += nvb) {
        const int hx = u & 3, b = (u >> 2) % NB, t0 = ((u >> 2) / NB) * 128 + w * 16, tq = t0 + lr;
        h8 qf[4];
#pragma unroll
        for (int c = 0; c < 4; ++c) { const half_t* qp = p.xq + ((long)b * T + tq) * 1024 + hx * 128 + c * 32 + lg * 8; qf[c] = *(const h8*)qp + *(const h8*)(qp + 512); }
        float m = -INFINITY, l = 0.f; f4 o[8];
#pragma unroll
        for (int q = 0; q < 8; ++q) o[q] = (f4){0.f, 0.f, 0.f, 0.f};
        const float scale = 0.08838834764831845f;
        int nx = 0;
        attn_block<128, true, 64>(smem, qf, m, l, o,
            [&](int& s0) { if (nx >= MEM) return false; s0 = nx; nx += 64; return true; },
            [&](int s0, int row, int ch) { return p.memkv + ((long)b * MEM + s0 + row) * 1024 + hx * 128 + ch * 8; },
            [&](int s0, int row, int ch) { return p.memkv + ((long)b * MEM + s0 + row) * 1024 + 512 + hx * 128 + ch * 8; },
            [&](int s0, f4 (&a)[4]) { (void)s0; a[0] = a[0] * (scale * LOG2E); a[1] = a[1] * (scale * LOG2E); a[2] = a[2] * (scale * LOG2E); a[3] = a[3] * (scale * LOG2E); return true; },
            [&](int) { return false; });
        l = rows4_sum(l);
        const float inv = 1.0f / l;
#pragma unroll
        for (int dt = 0; dt < 8; ++dt) {
            h4 ov;
#pragma unroll
            for (int r = 0; r < 4; ++r) ov[r] = (half_t)(o[dt][r] * inv);
            *(h4*)(p.xo + ((long)b * T + tq) * 512 + hx * 128 + dt * 16 + 4 * lg) = ov;
        }
    }
}

__device__ __forceinline__ float tshift(const half_t* pp, long row, int tt, int col, float mu) {
    const float cur = (float)pp[row * EVEN_IN + E_PB + col];
    float prv = (float)pp[(row > 0 ? row - 1 : 0) * EVEN_IN + E_PB + col];
    PIN(prv);
    prv = tt > 0 ? prv : 0.f;
    return cur + (prv - cur) * mu;
}
__device__ void ph_rwkv_prep(int vb, int nvb, char* smem_, const P& p) {
    const int tid = TIDX, lane = tid & 63, w = tid >> 6, lr = lane & 15, lg = lane >> 4;
    constexpr int WS = 72, GS = 136;
    half_t* sw = (half_t*)smem_; half_t* sa = sw + 256 * WS; half_t* sg = sa + 256 * WS;
    const int nh = vb & 1, ngrp = nvb >> 1;
    if (ngrp == 0) return;
    __syncthreads();
    for (int i = tid; i < 256 * 8; i += NT) { const int r = i >> 3, c8 = (i & 7) * 8;
        *(h8*)(sw + r * WS + c8) = *(const h8*)(p.wt_w2 + (nh * 256 + r) * 64 + c8); *(h8*)(sa + r * WS + c8) = *(const h8*)(p.wt_a2 + (nh * 256 + r) * 64 + c8); }
    for (int i = tid; i < 256 * 16; i += NT) { const int r = i >> 4, c8 = (i & 15) * 8; *(h8*)(sg + r * GS + c8) = *(const h8*)(p.wt_g2 + (nh * 256 + r) * 128 + c8); }
    __syncthreads();
    for (int tile = (vb >> 1) * NW + w; tile < M / 16; tile += ngrp * NW) {
        const long row = (long)tile * 16 + lr; const int tt = (int)(row % T);
        const half_t* cur = p.p + row * EVEN_IN + E_PB + 1536; const half_t* prv = p.p + (row > 0 ? row - 1 : 0) * EVEN_IN + E_PB + 1536;
        h8 xf[8];
#pragma unroll
        for (int c = 0; c < 8; ++c) {
            const h8 cv = *(const h8*)(cur + c * 32 + lg * 8); h8 pv = *(const h8*)(prv + c * 32 + lg * 8);
            const f4 m0 = *(const f4*)(p.b_mu + 1536 + c * 32 + lg * 8), m1 = *(const f4*)(p.b_mu + 1536 + c * 32 + lg * 8 + 4);
#pragma unroll
            for (int j = 0; j < 8; ++j) {
                const float cf = (float)cv[j], pf = tt > 0 ? (float)pv[j] : 0.f, mu = j < 4 ? m0[j] : m1[j - 4];
                const float v = cf + (pf - cf) * mu;
                xf[c][j] = (half_t)(c < 2 ? tanhf(v) : (c < 4 ? v : 1.0f / (1.0f + __expf(-v))));
            }
        }
        for (int nt = 0; nt < 16; ++nt) {
            const int n = nt * 16 + lr;
            f4 aw = (f4){0.f, 0.f, 0.f, 0.f}, aa = aw, ag = aw;
#pragma unroll
            for (int c = 0; c < 2; ++c) { aw = mfma16(*(const h8*)(sw + n * WS + c * 32 + lg * 8), xf[c], aw); aa = mfma16(*(const h8*)(sa + n * WS + c * 32 + lg * 8), xf[2 + c], aa); }
#pragma unroll
            for (int c = 0; c < 4; ++c) ag = mfma16(*(const h8*)(sg + n * GS + c * 32 + lg * 8), xf[4 + c], ag);
            const int ch = nh * 256 + nt * 16 + 4 * lg;
            const f4 w0 = *(const f4*)(p.b_w0 + ch), a0 = *(const f4*)(p.b_a0 + ch);
            h4 ol, oa, og;
#pragma unroll
            for (int r = 0; r < 4; ++r) {
                const float wr = w0[r] + aw[r];
                const float sp = fmaxf(-wr, 0.f) + __logf(1.0f + __expf(-fabsf(wr)));
                ol[r] = (half_t)__expf(-sp - 0.5f);
                oa[r] = (half_t)(1.0f / (1.0f + __expf(-(a0[r] + aa[r]))));
                og[r] = (half_t)ag[r];
            }
            *(h4*)(p.rwL + row * 512 + ch) = ol; *(h4*)(p.rwA + row * 512 + ch) = oa; *(h4*)(p.rwG + row * 512 + ch) = og;
        }
    }
}
constexpr int RC = 128, RNC = T / RC, RSC = 8;
constexpr int RWS = 72, RWM = 16 * RWS;
#ifdef CPU_EMU
#define RW_FENCE() WAVE_SYNC()
#else
#define RW_FENCE() asm volatile("s_waitcnt lgkmcnt(0)" ::: "memory")
#endif
__device__ __forceinline__ h4 cvt4(f4 v) { return (h4){(half_t)v[0], (half_t)v[1], (half_t)v[2], (half_t)v[3]}; }
__device__ __forceinline__ h8 cat8(h4 a, h4 b) { return (h8){a[0], a[1], a[2], a[3], b[0], b[1], b[2], b[3]}; }
__device__ __forceinline__ h8 op4(f4 v) { const h4 a = cvt4(v); const half_t z = (half_t)0.f; return (h8){a[0], a[1], a[2], a[3], z, z, z, z}; }
#ifdef CPU_EMU
typedef volatile unsigned* hs_ptr;
__device__ __forceinline__ void hs_wait(hs_ptr w, unsigned target) { while (*w < target) emu::yield(); }
__device__ __forceinline__ void hs_post(hs_ptr w, unsigned v) { WAVE_SYNC(); *w = v; }
#else
typedef volatile __attribute__((address_space(3))) unsigned* hs_ptr;
__device__ __forceinline__ void hs_wait(hs_ptr w, unsigned target) { while (*w < target) __builtin_amdgcn_s_sleep(1); asm volatile("" ::: "memory"); }
__device__ __forceinline__ void hs_post(hs_ptr w, unsigned v) { asm volatile("s_waitcnt lgkmcnt(0)" ::: "memory"); *w = v; }
#endif
template <int MODE>
__device__ void rwkv_chunk_wave(const P& p, int u, int c, float* vecs  , float* vown, hs_ptr hs, unsigned& seq) {
    const int lane = TIDX & 63, lr = lane & 15, lg = lane >> 4, b = u >> 3, hh = u & 7, ch = hh * 64 + lane;
    const long row0 = (long)b * T + (long)c * RC;
    float* cs = p.rwCS + (size_t)(u * RNC + c) * 8192;
    half_t* MA = (half_t*)vecs; half_t* MR = MA + RWM; half_t* MB = MR + RWM; half_t* MK = MB + RWM; half_t* MV = MK + RWM; half_t* MG = MV + RWM;
    float* fvec = (float*)(MG + RWM); float* bon = fvec + 64;
    const unsigned base = seq;
    f4 St[4][4];
    if (MODE == 2 && c > 0) {
        const float* sp = cs - 8192 + 4096;
#pragma unroll
        for (int kt = 0; kt < 4; ++kt)
#pragma unroll
            for (int vt = 0; vt < 4; ++vt) St[kt][vt] = *(const f4*)(sp + (16 * vt + lr) * 64 + 16 * kt + 4 * lg);
    } else {
#pragma unroll
        for (int kt = 0; kt < 4; ++kt)
#pragma unroll
            for (int vt = 0; vt < 4; ++vt)
#pragma unroll
                for (int r = 0; r < 4; ++r) St[kt][vt][r] = (MODE == 1 && (16 * kt + 4 * lg + r) == (16 * vt + lr)) ? 1.f : 0.f;
    }
    const float mur = p.b_mu[ch], muk = p.b_mu[512 + ch], muv = p.b_mu[1024 + ch], kkw = p.b_k_k[ch], kaw = p.b_k_a[ch];
    float pr = 0.f, pk = 0.f, pv = 0.f;
    if (c > 0) { const half_t* q = p.p + (row0 - 1) * EVEN_IN + E_PB + ch; pr = (float)q[0]; pk = (float)q[512]; pv = (float)q[1024]; }
    constexpr int NRAW = (MODE >= 2) ? 6 : 5;
    const float rkw = p.b_r_k[ch];
    half_t rawA[RSC][NRAW], rawB[RSC][NRAW];
    auto load_group = [&](half_t (&raw)[RSC][NRAW], int g) {
#pragma unroll
        for (int s2 = 0; s2 < RSC; ++s2) {
            const long row = row0 + g * RSC + s2;
            const half_t* q = p.p + row * EVEN_IN + E_PB + ch;
            raw[s2][0] = q[0]; raw[s2][1] = q[512]; raw[s2][2] = q[1024];
            raw[s2][3] = p.rwL[row * 512 + ch]; raw[s2][4] = p.rwA[row * 512 + ch];
            if (MODE >= 2) raw[s2][5] = p.rwG[row * 512 + ch];
        }
    };
    const f4 Z4 = (f4){0.f, 0.f, 0.f, 0.f};
    const h4 ZH = (h4){(half_t)0.f, (half_t)0.f, (half_t)0.f, (half_t)0.f};
    float carry = 0.f;
    if (MODE != 1) load_group(rawA, 0);
    auto set_image = [&](int sc) {
        float* vr = (sc & 1) ? vown : vecs;
        MA = (half_t*)vr; MR = MA + RWM; MB = MR + RWM; MK = MB + RWM; MV = MK + RWM; MG = MV + RWM; fvec = (float*)(MG + RWM); bon = fvec + 64;
    };
    auto expand_sub = [&](int sc, bool wr) {
        load_group(rawB, 2 * sc + 1);
        float Gm = 0.f;
#pragma unroll
        for (int s2 = 0; s2 < RSC; ++s2) Gm += (float)rawA[s2][3];
        Gm *= LOG2E;
        float G = 0.f, erp = fast_exp2(Gm);
        auto expand = [&](half_t (&cur)[RSC][NRAW], int t0) {
#pragma unroll
            for (int s2 = 0; s2 < RSC; ++s2) {
                const int t = t0 + s2;
                const float cr = (float)cur[s2][0], ck = (float)cur[s2][1], cv = (float)cur[s2][2];
                const float r = cr + (pr - cr) * mur, k0 = ck + (pk - ck) * muk, v = cv + (pv - cv) * muv;
                pr = cr; pk = ck; pv = cv;
                const float a = (float)cur[s2][4];
                G += (float)cur[s2][3] * LOG2E;
                const float er = fast_exp2(Gm - G), ek = fast_exp2(G - Gm);
                float kk = k0 * kkw;
                kk = kk * rsqrtf(fmaxf(wave_sum(kk * kk), 1e-24f));
                const float kp = k0 * (1.0f + (a - 1.0f) * kaw);
                if (wr) {
                    MA[t * RWS + lane] = (half_t)(-kk * erp);
                    MB[t * RWS + lane] = (half_t)(kk * a * ek);
                    if (MODE != 1) { MK[t * RWS + lane] = (half_t)(kp * ek); MV[t * RWS + lane] = (half_t)v; }
                }
                if (MODE >= 2) {
                    const float bs = wave_sum(r * kp * rkw);
                    if (wr) { MR[t * RWS + lane] = (half_t)(r * er); MG[t * RWS + lane] = cur[s2][NRAW - 1]; bon[t] = bs; }
                }
                erp = er;
            }
        };
        expand(rawA, 0);
        if (sc + 1 < RC / 16 && MODE != 2) load_group(rawA, 2 * sc + 2);
        expand(rawB, 8);
        if (wr) fvec[lane] = fast_exp2(carry - Gm);
        carry = Gm - G;
        RW_FENCE();
    };
    if (MODE == 2) { set_image(0); expand_sub(0, true); }
    for (int sc = 0; sc < RC / 16; ++sc) {
      if (MODE >= 2) set_image(sc);
      if (MODE == 2) { if (sc > 0) hs_wait(hs, base + sc); }
      else if (MODE != 1) {
        const bool wr = !(MODE == 3 && sc == 0);
        if (MODE == 0 && seq > 0) hs_wait(hs + 1, seq);
        if (MODE == 3 && sc > 0 && base + sc >= 2) hs_wait(hs + 1, base + sc - 1);
        expand_sub(sc, wr);
        if (MODE == 0) hs_post(hs, seq + 1);
        if (MODE == 3) { if (sc > 0) hs_post(hs, base + sc); continue; }
      } else hs_wait(hs, seq + 1);
        h8 SO[2][4];
        {
            h4 sh[4][4];
#pragma unroll
            for (int kt = 0; kt < 4; ++kt) {
                const f4 fv = *(const f4*)(fvec + 16 * kt + 4 * lg);
#pragma unroll
                for (int vt = 0; vt < 4; ++vt) { St[kt][vt] = St[kt][vt] * fv; sh[kt][vt] = cvt4(St[kt][vt]); }
            }
#pragma unroll
            for (int kk = 0; kk < 2; ++kk)
#pragma unroll
                for (int vt = 0; vt < 4; ++vt) SO[kk][vt] = cat8(sh[2 * kk][vt], sh[2 * kk + 1][vt]);
        }
        auto rowop = [&](const half_t* M, int kk) { const half_t* q = M + lr * RWS + 32 * kk + 4 * lg; return cat8(*(const h4*)q, *(const h4*)(q + 16)); };
        auto mm2 = [&](const h8 (&x)[2], const h8 (&y)[2]) { return mfma16(x[1], y[1], mfma16(x[0], y[0], Z4)); };
        const h8 AO[2] = {rowop(MA, 0), rowop(MA, 1)}, BO[2] = {rowop(MB, 0), rowop(MB, 1)};
        h8 KO[2] = {AO[0], AO[1]}, RO[2] = {AO[0], AO[1]};
        if (MODE != 1) { KO[0] = rowop(MK, 0); KO[1] = rowop(MK, 1); }
        if (MODE == 2) { RO[0] = rowop(MR, 0); RO[1] = rowop(MR, 1); }
        f4 Nn = mm2(AO, BO), X = mm2(BO, AO), TT;
#pragma unroll
        for (int r = 0; r < 4; ++r) {
            const int row = 4 * lg + r;
            Nn[r] = (lr < row) ? Nn[r] : 0.f; X[r] = (row < lr) ? X[r] : 0.f;
            TT[r] = X[r] + ((row == lr) ? 1.f : 0.f);
        }
        {
            const h8 oN = op4(Nn), oX = op4(X);
            const f4 X2 = mfma16(oN, oX, Z4), N2 = mfma16(oX, oN, Z4);
            const h8 oN2 = op4(N2), oX2 = op4(X2);
            TT = mfma16(oN2, op4(TT), TT);
            const f4 X4 = mfma16(oN2, oX2, Z4), N4 = mfma16(oX2, oN2, Z4);
            const h8 oN4 = op4(N4), oX4 = op4(X4);
            TT = mfma16(oN4, op4(TT), TT);
            const f4 N8 = mfma16(oX4, oN4, Z4);
            TT = mfma16(op4(N8), op4(TT), TT);
        }
        h8 oAK = AO[0], oAR = AO[0];
        if (MODE != 1) {
            f4 AK = mm2(KO, AO);
#pragma unroll
            for (int r = 0; r < 4; ++r) AK[r] = (4 * lg + r < lr) ? AK[r] : 0.f;
            oAK = op4(AK);
        }
        if (MODE == 2) {
            f4 RB = mm2(BO, RO), RK = mm2(KO, RO);
#pragma unroll
            for (int r = 0; r < 4; ++r) { const bool keep = 4 * lg + r <= lr; RB[r] = keep ? RB[r] : 0.f; RK[r] = keep ? RK[r] : 0.f; }
            oAR = cat8(cvt4(RB), cvt4(RK));
        }
        const int troff = (4 * lg + (lr >> 2)) * RWS + 4 * (lr & 3);
        h8 ZV[4];
        {
            const h8 oTT = op4(TT);
#pragma unroll
            for (int vt = 0; vt < 4; ++vt) {
                h4 vx = ZH;
                if (MODE != 1) vx = lds_tr_read(MV + troff + 16 * vt);
                f4 rhs = mfma16(AO[1], SO[1][vt], mfma16(AO[0], SO[0][vt], Z4));
                if (MODE != 1) rhs = mfma16(oAK, cat8(vx, ZH), rhs);
                const f4 z = mfma16(oTT, op4(rhs), Z4);
                ZV[vt] = cat8(cvt4(z), vx);
            }
        }
        if (MODE == 2) {
            f4 Y[4];
#pragma unroll
            for (int vt = 0; vt < 4; ++vt) Y[vt] = mfma16(ZV[vt], oAR, mfma16(SO[1][vt], RO[1], mfma16(SO[0][vt], RO[0], Z4)));
            float sum = 0.f;
#pragma unroll
            for (int vt = 0; vt < 4; ++vt) sum += (Y[vt][0] + Y[vt][1]) + (Y[vt][2] + Y[vt][3]);
            sum += SHFL_XOR(sum, 16); sum += SHFL_XOR(sum, 32);
            const float mean = sum * (1.0f / 64.0f);
            float var = 0.f;
#pragma unroll
            for (int vt = 0; vt < 4; ++vt)
#pragma unroll
                for (int r = 0; r < 4; ++r) { const float d = Y[vt][r] - mean; var += d * d; }
            var += SHFL_XOR(var, 16); var += SHFL_XOR(var, 32);
            const float rs = rsqrtf(var * (1.0f / 64.0f) + 64e-5f), bs = bon[lr];
            half_t* yo = p.y0 + (row0 + sc * 16 + lr) * D + 512 + hh * 64 + 4 * lg;
#pragma unroll
            for (int vt = 0; vt < 4; ++vt) {
                const f4 lw = *(const f4*)(p.b_ln_w + hh * 64 + 16 * vt + 4 * lg), lb = *(const f4*)(p.b_ln_b + hh * 64 + 16 * vt + 4 * lg);
                const h4 vv = *(const h4*)(MV + lr * RWS + 16 * vt + 4 * lg), gg = *(const h4*)(MG + lr * RWS + 16 * vt + 4 * lg);
                h4 o;
#pragma unroll
                for (int r = 0; r < 4; ++r) o[r] = (half_t)(((Y[vt][r] - mean) * rs * lw[r] + lb[r] + bs * (float)vv[r]) * (float)gg[r]);
                *(h4*)(yo + 16 * vt) = o;
            }
        }
#pragma unroll
        for (int kt = 0; kt < 4; ++kt) {
            h4 kx = ZH;
            if (MODE != 1) kx = lds_tr_read(MK + troff + 16 * kt);
            const h8 bk = cat8(lds_tr_read(MB + troff + 16 * kt), kx);
#pragma unroll
            for (int vt = 0; vt < 4; ++vt) St[kt][vt] = mfma16(bk, ZV[vt], St[kt][vt]);
        }
        RW_FENCE();
        if (MODE == 1) hs_post(hs + 1, seq + 1);
        if (MODE == 2) hs_post(hs + 1, base + sc + 1);
        if (MODE < 2) ++seq;
    }
    if (MODE >= 2) seq = base + RC / 16;
    if (MODE < 2) {
        if (MODE == 0) { hs_wait(hs + 1, seq); fvec[lane] = fast_exp2(carry); RW_FENCE(); hs_post(hs, seq + 1); }
        else hs_wait(hs, seq + 1);
        float* dst = cs + (MODE == 0 ? 4096 : 0);
        half_t* Hb = (half_t*)vown;
        f4 fvk[4];
#pragma unroll
        for (int kt = 0; kt < 4; ++kt) fvk[kt] = *(const f4*)(fvec + 16 * kt + 4 * lg);
        RW_FENCE();
        if (MODE == 1) hs_post(hs + 1, seq + 1);
        ++seq;
#pragma unroll
        for (int kt = 0; kt < 4; ++kt) {
            const f4 fv = fvk[kt];
#pragma unroll
            for (int vt = 0; vt < 4; ++vt) {
                const f4 sv = St[kt][vt] * fv;
                if (MODE == 0) *(f4*)(dst + (16 * vt + lr) * 64 + 16 * kt + 4 * lg) = sv;
                else *(h4*)(Hb + (16 * vt + lr) * RWS + 16 * kt + 4 * lg) = cvt4(sv);
            }
        }
        RW_FENCE();
        if (MODE == 1) {
            half_t* mh = p.rwMh + (size_t)(u * RNC + c) * 4096;
#pragma unroll
            for (int rt = 0; rt < 4; ++rt)
#pragma unroll
                for (int ct = 0; ct < 4; ++ct) {
                    const h4 x = lds_tr_read(Hb + (16 * rt + 4 * lg + (lr >> 2)) * RWS + 16 * ct + 4 * (lr & 3));
                    *(h4*)(mh + (16 * ct + lr) * 64 + 16 * rt + 4 * lg) = x;
                }
            RW_FENCE();
        }
    }
}
__device__ void ph_rwkv_pass1(int vb, int nvb, char* smem_, const P& p) {
    const int w = TIDX >> 6;
    float* vown = (float*)smem_ + w * (RSC * 448 + 16);
    float* vl = (float*)smem_ + (w & 3) * (RSC * 448 + 16);
    unsigned* hsw = (unsigned*)((float*)smem_ + NW * (RSC * 448 + 16));
    __syncthreads();
    if (TIDX < 8) hsw[TIDX] = 0u;
    __syncthreads();
    hs_ptr hs = (hs_ptr)(hsw + 2 * (w & 3));
    unsigned seq = 0;
    for (int item = vb * 4 + (w & 3); item < NB * 8 * RNC; item += nvb * 4) {
        const int u = item / RNC, c = item % RNC;
        if (w >> 2) rwkv_chunk_wave<1>(p, u, c, vl, vown, hs, seq); else rwkv_chunk_wave<0>(p, u, c, vl, vown, hs, seq);
    }
}
struct P2Regs { h8 a[4][2]; f4 L[4]; };
template <bool WIDE>
__device__ void rwkv_pass2_block(const P& p, int u2) {
    const int lane = TIDX & 63, w8 = TIDX >> 6, wv = w8 & 3, u = WIDE ? u2 : 2 * u2 + (w8 >> 2), lr = lane & 15, g = lane >> 4, v = 16 * wv + lr;
    if (WIDE && w8 >= 4) return;
    f4 Dd[4];
#pragma unroll
    for (int i = 0; i < 4; ++i) Dd[i] = (f4){0.f, 0.f, 0.f, 0.f};
    auto load = [&](P2Regs& R, int c) {
        const int cc = c < RNC - 1 ? c : RNC - 2;
        const half_t* mh = p.rwMh + (size_t)(u * RNC + cc) * 4096;
        const float* lc = p.rwCS + (size_t)(u * RNC + cc) * 8192 + 4096 + v * 64;
#pragma unroll
        for (int nt = 0; nt < 4; ++nt) {
#pragma unroll
            for (int kk = 0; kk < 2; ++kk) { const half_t* q = mh + (16 * nt + lr) * 64 + 32 * kk + 4 * g; R.a[nt][kk] = cat8(*(const h4*)q, *(const h4*)(q + 16)); }
            R.L[nt] = *(const f4*)(lc + 16 * nt + 4 * g);
        }
    };
    auto body = [&](P2Regs& R, int c) {
        const h8 s0 = cat8(cvt4(Dd[0]), cvt4(Dd[1])), s1 = cat8(cvt4(Dd[2]), cvt4(Dd[3]));
        float* lc = p.rwCS + (size_t)(u * RNC + c) * 8192 + 4096 + v * 64;
#pragma unroll
        for (int nt = 0; nt < 4; ++nt) { f4 acc = mfma16(R.a[nt][1], s1, mfma16(R.a[nt][0], s0, R.L[nt])); Dd[nt] = acc; *(f4*)(lc + 16 * nt + 4 * g) = acc; }
    };
    P2Regs R0, R1, R2;
    load(R0, 0); load(R1, 1); load(R2, 2);
    for (int c = 0; c < RNC - 1; c += 3) {
        body(R0, c); load(R0, c + 3);
        if (c + 1 < RNC - 1) { body(R1, c + 1); load(R1, c + 4); }
        if (c + 2 < RNC - 1) { body(R2, c + 2); load(R2, c + 5); }
    }
}
__device__ void ph_rwkv_pass3(int vb, int nvb, char* smem_, const P& p) {
    const int w = TIDX >> 6;
    float* regA = (float*)smem_ + (w & 3) * (RSC * 448 + 16);
    float* regB = (float*)smem_ + ((w & 3) + 4) * (RSC * 448 + 16);
    unsigned* hsw = (unsigned*)((float*)smem_ + NW * (RSC * 448 + 16));
    __syncthreads();
    if (TIDX < 8) hsw[TIDX] = 0u;
    __syncthreads();
    hs_ptr hs = (hs_ptr)(hsw + 2 * (w & 3));
    unsigned seq = 0;
    if (w >= 4) {
        const int wv = vb * 4 + (w - 4), nwv = nvb * 4;
        wave_transpose_w<32>(wv, nwv, regB, p.ff_w1, D, DFF, p.wt_f1, p.norm_gains + 4 * D);
        wave_transpose_w<32>(wv, nwv, regB, p.ff_w2, DFF, D, p.wt_f2, nullptr);
        WAVE_SYNC();
    }
    for (int gw = vb * 4 + (w & 3); gw < NB * 8 * RNC; gw += nvb * 4) {
        if (w < 4) rwkv_chunk_wave<2>(p, gw / RNC, gw % RNC, regA, regB, hs, seq); else rwkv_chunk_wave<3>(p, gw / RNC, gw % RNC, regA, regB, hs, seq);
    }
}
__device__ void ph_rwkv_post(int vb, int nvb, const P& p) {
    const int lane = TIDX & 63, w = TIDX >> 6;
    for (long u = (long)vb * NW + w; u < (long)M * 8; u += (long)nvb * NW) {
        const long row = u >> 3; const int hh = (int)(u & 7), c = hh * 64 + lane, tt = (int)(row % T);
        const float y = (float)p.rwY16[row * 512 + c];
        const float mean = wave_sum(y) * (1.0f / 64.0f);
        const float dlt = y - mean;
        const float var = wave_sum(dlt * dlt) * (1.0f / 64.0f);
        const float yn = dlt * rsqrtf(var + 64e-5f) * p.b_ln_w[c] + p.b_ln_b[c];
        const float r = tshift(p.p, row, tt, c, p.b_mu[c]), k0 = tshift(p.p, row, tt, 512 + c, p.b_mu[512 + c]), v = tshift(p.p, row, tt, 1024 + c, p.b_mu[1024 + c]);
        const float a = (float)p.rwA[row * 512 + c];
        const float k = k0 * (1.0f + (a - 1.0f) * p.b_k_a[c]);
        const float bonus = wave_sum(r * k * p.b_r_k[c]) * v;
        p.y0[row * D + 512 + c] = (half_t)((yn + bonus) * (float)p.rwG[row * 512 + c]);
    }
}

__device__ void ph_moba_kmean(int vb, int nvb, char* smem_, const P& p) {
    float* red = (float*)smem_;
    const int tid = TIDX, c = tid & 127, qtr = tid >> 7;
    for (int u = vb; u < NB * NBLK; u += nvb) {
        const int blk = u % NBLK, b = u / NBLK;
        float s = 0.f;
        const half_t* base = p.p + ((long)b * T + blk * 256 + qtr * 64) * ODD_PAD + O_KC + c;
#pragma unroll 8
        for (int r = 0; r < 64; ++r) s += (float)base[(long)r * ODD_PAD];
        __syncthreads();
        red[tid] = s;
        __syncthreads();
        if (tid < 128) p.kmean[(long)u * 128 + c] = ((red[c] + red[128 + c]) + (red[256 + c] + red[384 + c])) * (1.0f / 256.0f);
    }
}
__device__ void ph_moba_gate(int vb, int nvb, char* smem_, const P& p) {
    float* km = (float*)smem_;
    const int tid = TIDX;
    for (int u = vb; u < M / 256; u += nvb) {
        const long row = (long)u * 256 + (tid >> 1); const int kvh = tid & 1, b = (int)(row / T), t = (int)(row % T), own = t >> 8;
        const int ownmax = (int)(((long)u * 256 + 255) % T) >> 8;
        __syncthreads();
        for (int i = tid; i < ownmax * 128; i += NT) km[i] = p.kmean[(long)b * NBLK * 128 + i];
        __syncthreads();
        float best[3] = {-INFINITY, -INFINITY, -INFINITY}; int bi[3] = {-1, -1, -1};
        if (own > 0) {
            float qs[64];
#pragma unroll
            for (int d = 0; d < 64; ++d) qs[d] = 0.f;
#pragma unroll
            for (int g = 0; g < 4; ++g)
#pragma unroll
                for (int d8 = 0; d8 < 8; ++d8) { h8 v = *(const h8*)(p.p + row * ODD_PAD + O_QC + (kvh * 4 + g) * 64 + d8 * 8);
#pragma unroll
                    for (int j = 0; j < 8; ++j) qs[d8 * 8 + j] += (float)v[j]; }
            for (int n = 0; n < own; ++n) {
                const float* kr = km + n * 128 + kvh * 64;
                float g0 = 0.f, g1 = 0.f, g2 = 0.f, g3 = 0.f;
#pragma unroll
                for (int d = 0; d < 64; d += 4) { f4 kv4 = *(const f4*)(kr + d); g0 += qs[d] * kv4[0]; g1 += qs[d + 1] * kv4[1]; g2 += qs[d + 2] * kv4[2]; g3 += qs[d + 3] * kv4[3]; }
                const float gsum = (g0 + g1) + (g2 + g3);
                if (gsum > best[0]) { best[2] = best[1]; bi[2] = bi[1]; best[1] = best[0]; bi[1] = bi[0]; best[0] = gsum; bi[0] = n; }
                else if (gsum > best[1]) { best[2] = best[1]; bi[2] = bi[1]; best[1] = gsum; bi[1] = n; }
                else if (gsum > best[2]) { best[2] = gsum; bi[2] = n; }
            }
        }
        unsigned mk = 0;
#pragma unroll
        for (int q = 0; q < 3; ++q) if (bi[q] >= 0) mk |= 1u << bi[q];
        p.mmask[row * 2 + kvh] = (unsigned short)mk;
    }
}
__device__ void ph_moba(int vb, int nvb, char* smem, const P& p) {
    const int tid = TIDX, w = tid >> 6, lane = tid & 63, lr = lane & 15, lg = lane >> 4, hd = lr & 3, qi = lr >> 2;
    const half_t* pp = p.p; const int ld = ODD_PAD;
    constexpr int MOBA_BUF = 2 * ATile<64, 128>::BUF;
    constexpr int RTN = 1024 + 81;
    float* rtb = (float*)(smem + MOBA_BUF);
    const float* rt = rtb + hd * RTN;
    unsigned* umx = (unsigned*)(smem + MOBA_BUF + 4 * RTN * 4);
    const int nunits = NB * 2 * (T / 32);
    int lastkv = -1;
    for (int i = 0;; ++i) {
        const int u = snake_unit(i, vb, nvb);
        if (u >= nunits) break;
        const int kvh = u & 1, b = (u >> 1) % NB, t0g = (T / 32 - 1 - (u >> 1) / NB) * 32, t0 = t0g + w * 4, hh = kvh * 4 + hd, tq = t0 + qi, own = t0g >> 8;
        h8 qf[2];
#pragma unroll
        for (int c = 0; c < 2; ++c) qf[c] = *(const h8*)(pp + ((long)b * T + tq) * ld + O_QC + hh * 64 + c * 32 + lg * 8);
        const unsigned mymask = p.mmask[((long)b * T + tq) * 2 + kvh];
        unsigned um = mymask;
        um |= SHFL_XOR(um, 4); um |= SHFL_XOR(um, 8);
        um = SHFL_IDX(um, 0);
        const unsigned umw = um;
        __syncthreads();
        if (kvh != lastkv) { for (int j = tid; j < 4 * RTN; j += NT) { const int h = j / RTN, jj = j % RTN; rtb[j] = (jj < 1024) ? p.bias_dist[(kvh * 4 + h) * 4096 + 1023 - jj] * LOG2E : 0.f; } lastkv = kvh; }
        if (lane == 0) umx[w] = um;
        __syncthreads();
        um = (umx[0] | umx[1]) | (umx[2] | umx[3]) | (umx[4] | umx[5]) | (umx[6] | umx[7]);
        float m = -INFINITY, l = 0.f; f4 o[4];
#pragma unroll
        for (int q = 0; q < 4; ++q) o[q] = (f4){0.f, 0.f, 0.f, 0.f};
        const int nt_own = (t0g + 31 - own * 256) / 128 + 1;
        int blk = 0, st = 0;
        attn_block<64, true, 128>(smem, qf, m, l, o,
            [&](int& s0) {
                for (;;) {
                    if (blk > own) return false;
                    const bool live = (blk == own) || ((um >> blk) & 1);
                    if (live && st < ((blk == own) ? nt_own : 2)) break;
                    ++blk; st = 0;
                }
                s0 = blk * 256 + st * 128; ++st; return true;
            },
            [&](int s0, int row, int ch) { return pp + ((long)b * T + s0 + row) * ld + O_KC + kvh * 64 + ch * 8; },
            [&](int s0, int row, int ch) { return pp + ((long)b * T + s0 + row) * ld + E_VA + kvh * 64 + ch * 8; },
            [&](int s0, f4 (&a)[4]) {
                const int kb = s0 >> 8; const bool sel = (kb == own) || ((mymask >> kb) & 1);
                if (t0g - (s0 + 63) >= 790) {
                    const float bc = rt[0];
#pragma unroll
                    for (int kt = 0; kt < 4; ++kt) a[kt] = a[kt] * (0.125f * LOG2E) + bc;
                } else {
                    const int dq = tq - s0 - 4 * lg;
                    const float* rb = rt + (1023 - dq);
                    if (s0 + 63 <= t0) {
#pragma unroll
                        for (int kt = 0; kt < 4; ++kt)
#pragma unroll
                            for (int q = 0; q < 4; ++q) a[kt][q] = a[kt][q] * (0.125f * LOG2E) + rb[kt * 16 + q];
                    } else {
#pragma unroll
                        for (int kt = 0; kt < 4; ++kt)
#pragma unroll
                            for (int q = 0; q < 4; ++q) a[kt][q] = (kt * 16 + q <= dq) ? a[kt][q] * (0.125f * LOG2E) + rb[kt * 16 + q] : -INFINITY;
                    }
                }
                return sel;
            },
            [&](int s0) { const int kb = s0 >> 8; return (kb == own) ? (s0 > t0 + 3) : !((umw >> kb) & 1); });
        l = rows4_sum(l);
        const float inv = 1.0f / l;
#pragma unroll
        for (int dt = 0; dt < 4; ++dt) {
            h4 ov;
#pragma unroll
            for (int r = 0; r < 4; ++r) ov[r] = (half_t)(o[dt][r] * inv);
            *(h4*)(p.y1 + ((long)b * T + tq) * D + hh * 64 + dt * 16 + 4 * lg) = ov;
        }
    }
}

__device__ void ph_dsa_kin(int vb, int nvb, const P& p) {
    const int lane = TIDX & 63, w = TIDX >> 6;
    for (long row = (long)vb * NW + w; row < M; row += (long)nvb * NW) {
        const float v = (float)p.p[row * ODD_PAD + O_KI + lane];
        const float ss = wave_sum(v * v);
        p.kin[row * 64 + lane] = (half_t)(v * rsqrtf(ss * (1.0f / 64.0f) + EPS) * p.d_kidx_norm[lane]);
        if (lane < 16) *(h8*)(p.kvd + row * 128 + lane * 8) = *(const h8*)(p.p + row * ODD_PAD + O_KD + lane * 8);
    }
}
__device__ __forceinline__ u4 zero_u4() {
    unsigned z = 0u;
#ifndef CPU_EMU
    asm volatile("" : "+v"(z));
#endif
    return (u4){z, z, z, z};
}
__device__ __forceinline__ int mbcnt64(unsigned long long m) {
#ifdef CPU_EMU
    const int lane = (int)(threadIdx.x & 63); return __builtin_popcountll(lane ? (m & (~0ull >> (64 - lane))) : 0ull);
#else
    return (int)__builtin_amdgcn_mbcnt_hi((unsigned)(m >> 32), __builtin_amdgcn_mbcnt_lo((unsigned)m, 0u));
#endif
}
__device__ __forceinline__ unsigned fkey(float f) { unsigned u = __builtin_bit_cast(unsigned, f); return (u & 0x80000000u) ? ~u : (u | 0x80000000u); }
__device__ __forceinline__ void dsa_select_wave(const float* sr, int t, unsigned short* out, unsigned* hist, unsigned* dump  ) {
    const int lane = TIDX & 63;
    constexpr int NJ = T / 64;
    const int n = t + 1;
    if (n <= DSA_K) { for (int i = lane; i < n; i += 64) out[i] = (unsigned short)i; return; }
    unsigned u[NJ];
#ifdef CPU_EMU
    const int nj = (n + 63) >> 6;
#else
    const int nj = __builtin_amdgcn_readfirstlane((n + 63) >> 6);
#endif
    static_assert(NJ % 4 == 0 || NJ < 4, "row quarters");
    constexpr int QJ = NJ >= 4 ? NJ / 4 : NJ;
    auto rows = [&](auto&& f) __attribute__((always_inline)) {
#pragma unroll
        for (int j = 0; j < QJ; ++j) f(j);
        if (NJ > QJ && nj > QJ) {
#pragma unroll
            for (int j = QJ; j < 2 * QJ; ++j) f(j);
            if (nj > 2 * QJ) {
#pragma unroll
                for (int j = 2 * QJ; j < 3 * QJ; ++j) f(j);
                if (nj > 3 * QJ) {
#pragma unroll
                    for (int j = 3 * QJ; j < NJ; ++j) f(j);
                }
            }
        }
    };
    rows([&](int j) __attribute__((always_inline)) { u[j] = __builtin_bit_cast(unsigned, sr[(j < nj ? j : 0) * 64 + lane]); });
    rows([&](int j) __attribute__((always_inline)) { unsigned v = u[j]; PIN(v); u[j] = (j * 64 + lane < n) ? fkey(__builtin_bit_cast(float, v)) : 0u; });
    unsigned prefix = 0u, pmask = 0u; int kk = DSA_K; bool exact = false;
    for (int level = 0; level < 3; ++level) {
        const int shift = level == 0 ? 21 : (level == 1 ? 10 : 0);
        const unsigned bmask = level == 2 ? 1023u : 2047u;
        if (level > 0) {
            WAVE_SYNC();
#pragma unroll
            for (int q = 0; q < 8; ++q) *(u4*)(hist + lane * 32 + q * 4) = zero_u4();
            WAVE_SYNC();
            rows([&](int j) __attribute__((always_inline)) {
                const bool hit = u[j] != 0u && (u[j] & pmask) == prefix;
                unsigned* dst = hit ? hist + ((u[j] >> shift) & bmask) : dump + lane;
#ifdef CPU_EMU
                *dst += 1u;
#else
                (void)__hip_atomic_fetch_add((__attribute__((address_space(3))) unsigned*)dst, 1u, __ATOMIC_RELAXED, __HIP_MEMORY_SCOPE_WORKGROUP);
#endif
            });
        }
        WAVE_SYNC();
        const int b0 = 2048 - 32 * (lane + 1);
        unsigned hb[32]; unsigned sl = 0;
#pragma unroll
        for (int q = 0; q < 8; ++q) { const u4 v = *(const u4*)(hist + b0 + q * 4);
#pragma unroll
            for (int e = 0; e < 4; ++e) { hb[q * 4 + e] = v[e]; sl += v[e]; } }
        const unsigned pre = wave_prefix_sum(sl);
        const unsigned long long bm = __ballot((int)pre >= kk);
        const int L = bm ? __builtin_ctzll(bm) : 63;
        int tb = -1; unsigned ca = 0, bc = 0, run = pre - sl;
#pragma unroll
        for (int q = 31; q >= 0; --q) { const bool hit = (tb < 0) && ((int)(run + hb[q]) >= kk); if (hit) { tb = q; ca = run; bc = hb[q]; } run += hb[q]; }
        const int tbin = (int)bcast_u((unsigned)(tb + b0), L); const unsigned cab = bcast_u(ca, L), bcn = bcast_u(bc, L);
        kk -= (int)cab; prefix |= (unsigned)tbin << shift; pmask |= bmask << shift;
        if ((int)bcn == kk) { exact = true; break; }
    }
    const unsigned thr = prefix;
    const int need = kk;
    unsigned short* ol = (unsigned short*)(hist + 2048 - 160);
    WAVE_SYNC();
    if (exact) {
        int mine = 0;
        rows([&](int j) __attribute__((always_inline)) { mine += (u[j] >= thr) ? 1 : 0; });
        int pos = (int)wave_prefix_sum((unsigned)mine) - mine;
        rows([&](int j) __attribute__((always_inline)) {
            const bool sel = u[j] >= thr;
            ol[sel ? pos : 256 + lane] = (unsigned short)(j * 64 + lane);
            pos += sel ? 1 : 0;
        });
    } else {
        int eqbase = 0, pos = 0;
        rows([&](int j) __attribute__((always_inline)) {
            const bool eq = (u[j] == thr);
            const unsigned long long beq = __ballot(eq);
            const int erank = eqbase + mbcnt64(beq);
            const bool sel = (u[j] > thr) || (eq && erank < need);
            const unsigned long long bs = __ballot(sel);
            if (sel) ol[pos + mbcnt64(bs)] = (unsigned short)(j * 64 + lane);
            eqbase += __popcll(beq); pos += __popcll(bs);
        });
    }
    WAVE_SYNC();
    { typedef unsigned long long __attribute__((may_alias)) u64a;
#ifndef CPU_EMU
      asm volatile("s_waitcnt lgkmcnt(0)" ::: "memory");
#endif
      *(u64a*)(out + lane * 4) = *(const u64a*)(ol + lane * 4); }
}
__device__ __forceinline__ void ph_dsa_index(int vb, int nvb, char* smem_, const P& p) {
    const int lane = TIDX & 63, w = TIDX >> 6, lr = lane & 15, lg = lane >> 4;
    const int nt = T / 16, nunits = NB * nt;
    float* scr = p.scores + (long)vb * 16 * SCS;
    for (int i = 0;; ++i) {
        const int un = snake_unit(i, vb, nvb);
        if (un >= nunits) break;
        const int b = un % NB, t0 = (nt - 1 - un / NB) * 16, tq = t0 + lr;
        const long row = (long)b * T + tq;
        h8 qf[4][2]; float wv[4];
#pragma unroll
        for (int ih = 0; ih < 4; ++ih) {
            wv[ih] = (float)p.p[row * ODD_PAD + O_WI + ih] * 0.0625f;
#pragma unroll
            for (int c = 0; c < 2; ++c) qf[ih][c] = *(const h8*)(p.p + row * ODD_PAD + O_QI + ih * 64 + c * 32 + lg * 8);
        }
        __syncthreads();
        unsigned* hq = (unsigned*)smem_;
        { const u4 zz = zero_u4(); for (int i = TIDX; i < 16 * 2048 / 4; i += NT) ((u4*)hq)[i] = zz; }
        __syncthreads();
        const int nkt = t0 / 16 + 1;
        auto ldk = [&](h8 (&kf)[2], int kt) {
            const int kc = kt < nkt ? kt : nkt - 1;
#pragma unroll
            for (int c = 0; c < 2; ++c) kf[c] = *(const h8*)(p.kin + ((long)b * T + kc * 16 + lr) * 64 + c * 32 + lg * 8);
        };
        auto score = [&](const h8 (&kf)[2], int kt) {
            f4 sc = (f4){0.f, 0.f, 0.f, 0.f};
#pragma unroll
            for (int ih = 0; ih < 4; ++ih) {
                f4 acc = (f4){0.f, 0.f, 0.f, 0.f};
                acc = mfma16(kf[0], qf[ih][0], acc); acc = mfma16(kf[1], qf[ih][1], acc);
#pragma unroll
                for (int r = 0; r < 4; ++r) sc[r] += wv[ih] * fmaxf(acc[r], 0.f);
            }
            *(f4*)(scr + (long)lr * SCS + kt * 16 + 4 * lg) = sc;
#pragma unroll
            for (int r = 0; r < 4; ++r) {
                unsigned* dst = (kt * 16 + 4 * lg + r <= tq) ? hq + lr * 2048 + (fkey(sc[r]) >> 21) : (unsigned*)(smem_ + 131072) + w * 64 + lane;
#ifdef CPU_EMU
                *dst += 1u;
#else
                (void)__hip_atomic_fetch_add((__attribute__((address_space(3))) unsigned*)dst, 1u, __ATOMIC_RELAXED, __HIP_MEMORY_SCOPE_WORKGROUP);
#endif
            }
        };
        h8 kA[2], kB[2];
        ldk(kA, w);
        for (int kt = w; kt < nkt; kt += 2 * NW) {
            ldk(kB, kt + NW);
            SCHED_FENCE();
            score(kA, kt);
            if (kt + NW >= nkt) break;
            ldk(kA, kt + 2 * NW);
            SCHED_FENCE();
            score(kB, kt + NW);
        }
        __syncthreads();
        for (int qi = w; qi < 16; qi += NW) dsa_select_wave(scr + (long)qi * SCS, t0 + qi, p.dsel + ((long)b * T + t0 + qi) * 256, hq + qi * 2048, (unsigned*)(smem_ + 131072) + w * 64);
    }
}
struct DsaRegs { h8 kf[2][2]; h8 vr[4]; int s0; };
constexpr int DVS = 72;
__device__ void ph_dsa(int vb, int nvb, char* smem_, const P& p) {
    const int tid = TIDX, w = tid >> 6, lane = tid & 63, lr = lane & 15, lg = lane >> 4, hh = lr & 7;
    constexpr int BTS = 1025;
    float* btab = (float*)smem_;
    unsigned short* sidx = (unsigned short*)(smem_ + 33024) + w * 512;
    unsigned short* sdist = (unsigned short*)(smem_ + 33024 + 8192) + w * 512;
    half_t* vbuf = (half_t*)(smem_ + 33024 + 16384) + w * (32 * DVS);
    __syncthreads();
    for (int i = tid; i < 8 * 1024; i += NT) btab[(i >> 10) * BTS + (i & 1023)] = p.bias_dist[(i >> 10) * 4096 + (i & 1023)] * LOG2E;
    __syncthreads();
    const half_t* pp = p.p; const int ld = ODD_PAD;
    const float* bd = btab + hh * BTS;
    long stride = (long)nvb * NW, row = (long)vb * NW + w, rend = M;
    if ((nvb & 7) == 0 && (8 % NB) == 0) {
        const int xpb = 8 / NB, x = vb & 7, part = x % xpb, wid = (vb >> 3) * NW + w, wpx = (nvb >> 3) * NW;
        row = (long)(x / xpb) * T + (long)wid * xpb + part; stride = (long)wpx * xpb; rend = (long)(x / xpb + 1) * T;
    }
    if (row >= rend) return;
    typedef unsigned long long __attribute__((may_alias)) u64a;
    auto fetch_sel = [&](long r) { return *(const u64a*)(p.dsel + r * 256 + lane * 4); };
    auto put_sel = [&](u64a v, int t, int buf) {
        u64a dv = 0;
#pragma unroll
        for (int e = 0; e < 4; ++e) { int d = t - (int)((v >> (16 * e)) & 0xffffu); d = d < 0 ? 0 : (d > 1023 ? 1023 : d); dv |= (u64a)(unsigned)d << (16 * e); }
        WAVE_SYNC();
        *(u64a*)(sidx + buf * 256 + lane * 4) = v; *(u64a*)(sdist + buf * 256 + lane * 4) = dv;
#ifndef CPU_EMU
        asm volatile("s_waitcnt lgkmcnt(0)" ::: "memory");
#endif
        WAVE_SYNC();
    };
    auto load_q = [&](h8 (&qf)[2], long r) {
#pragma unroll
        for (int c = 0; c < 2; ++c) qf[c] = *(const h8*)(pp + r * ld + O_QD + hh * 64 + c * 32 + lg * 8);
    };
    auto load = [&](DsaRegs& r, long rb, int cnt, int buf, int s0) {
        r.s0 = s0;
        const unsigned short* si = sidx + buf * 256;
        const int sl0 = s0 + lr, sl1 = s0 + 16 + lr, slv = s0 + (lane >> 1);
        int key0 = si[sl0 < cnt ? sl0 : cnt - 1], key1 = si[sl1 < cnt ? sl1 : cnt - 1], keyv = si[slv < cnt ? slv : cnt - 1];
#ifndef CPU_EMU
        asm volatile("" : "+v"(key0), "+v"(key1), "+v"(keyv));
#endif
#pragma unroll
        for (int c = 0; c < 2; ++c) { r.kf[0][c] = *(const h8*)(p.kvd + (rb + key0) * 128 + c * 32 + lg * 8); r.kf[1][c] = *(const h8*)(p.kvd + (rb + key1) * 128 + c * 32 + lg * 8); }
        { const half_t* vrow = p.kvd + (rb + keyv) * 128 + 64 + (lane & 1) * 32;
#pragma unroll
          for (int q = 0; q < 4; ++q) r.vr[q] = *(const h8*)(vrow + q * 8); }
    };
    float m = -INFINITY, l = 0.f; f4 o[4];
    auto compute = [&](DsaRegs& r, const h8 (&qf)[2], int cnt, int buf) {
        WAVE_SYNC();
#ifdef CPU_EMU
#pragma unroll
        for (int q = 0; q < 4; ++q) *(h8*)(vbuf + (lane >> 1) * DVS + (lane & 1) * 32 + q * 8) = r.vr[q];
#else
#pragma unroll
        for (int q = 0; q < 4; ++q) *(__attribute__((address_space(3))) h8*)(vbuf + (lane >> 1) * DVS + (lane & 1) * 32 + q * 8) = r.vr[q];
        asm volatile("s_waitcnt lgkmcnt(0)" ::: "memory");
#endif
        WAVE_SYNC();
        const unsigned short* sd = sdist + buf * 256;
        float bv[2][4];
        {
            typedef unsigned long long __attribute__((may_alias)) u64b;
            u64b d0 = *(const u64b*)(sd + r.s0 + 4 * lg), d1 = *(const u64b*)(sd + r.s0 + 16 + 4 * lg);
#ifndef CPU_EMU
            asm volatile("" : "+v"(d0), "+v"(d1));
#endif
#pragma unroll
            for (int q = 0; q < 4; ++q) { bv[0][q] = bd[(int)((d0 >> (16 * q)) & 0xffffu)]; bv[1][q] = bd[(int)((d1 >> (16 * q)) & 0xffffu)]; }
#ifndef CPU_EMU
            asm volatile("" : "+v"(bv[0][0]), "+v"(bv[0][1]), "+v"(bv[0][2]), "+v"(bv[0][3]), "+v"(bv[1][0]), "+v"(bv[1][1]), "+v"(bv[1][2]), "+v"(bv[1][3]));
#endif
        }
        f4 sv[2];
#pragma unroll
        for (int tl = 0; tl < 2; ++tl) {
            f4 acc = (f4){0.f, 0.f, 0.f, 0.f};
#pragma unroll
            for (int c = 0; c < 2; ++c) acc = mfma16(r.kf[tl][c], qf[c], acc);
#pragma unroll
            for (int q = 0; q < 4; ++q) {
                const int sl2 = r.s0 + tl * 16 + 4 * lg + q;
                const float sc = acc[q] * (0.125f * LOG2E) + bv[tl][q];
                acc[q] = (sl2 < cnt) ? sc : -INFINITY;
            }
            sv[tl] = acc;
        }
        h8 vf[4];
#pragma unroll
        for (int dt = 0; dt < 4; ++dt) {
            const half_t* a0 = vbuf + (4 * lg + (lr >> 2)) * DVS + dt * 16 + 4 * (lr & 3);
            const h4 x = lds_tr_read(a0), y = lds_tr_read(a0 + 16 * DVS);
            vf[dt] = (h8){x[0], x[1], x[2], x[3], y[0], y[1], y[2], y[3]};
        }
        attn_step<4>(sv[0], sv[1], vf, m, l, o);
    };
    int t = (int)(row % T); long rb = row - t; int cnt = (t + 1 < DSA_K) ? t + 1 : DSA_K; int buf = 0;
    put_sel(fetch_sel(row), t, 0);
    h8 qf[2], nqf[2];
    load_q(qf, row);
    DsaRegs R0, R1, R2, R3;
    load(R0, rb, cnt, 0, 0); load(R1, rb, cnt, 0, 32); load(R2, rb, cnt, 0, 64);
    for (;;) {
        const long nrow = row + stride; const bool hn = nrow < rend;
        const long nr = hn ? nrow : row; const int nt = (int)(nr % T); const long nrb = nr - nt; const int ncnt = (nt + 1 < DSA_K) ? nt + 1 : DSA_K;
        const u64a nsv = fetch_sel(nr);
        m = -INFINITY; l = 0.f;
#pragma unroll
        for (int i = 0; i < 4; ++i) o[i] = (f4){0.f, 0.f, 0.f, 0.f};
        load(R3, rb, cnt, buf, 96); SCHED_FENCE(); compute(R0, qf, cnt, buf);
        load(R0, rb, cnt, buf, 128); SCHED_FENCE(); compute(R1, qf, cnt, buf);
        load(R1, rb, cnt, buf, 160); SCHED_FENCE(); compute(R2, qf, cnt, buf);
        put_sel(nsv, nt, buf ^ 1); load_q(nqf, nr);
        load(R2, rb, cnt, buf, 192); SCHED_FENCE(); compute(R3, qf, cnt, buf);
        load(R3, rb, cnt, buf, 224); SCHED_FENCE(); compute(R0, qf, cnt, buf);
        load(R0, nrb, ncnt, buf ^ 1, 0); SCHED_FENCE(); compute(R1, qf, cnt, buf);
        load(R1, nrb, ncnt, buf ^ 1, 32); SCHED_FENCE(); compute(R2, qf, cnt, buf);
        load(R2, nrb, ncnt, buf ^ 1, 64); SCHED_FENCE(); compute(R3, qf, cnt, buf);
        l = rows4_sum(l);
        const float inv = 1.0f / l;
        if (lr < 8) {
#pragma unroll
            for (int dt = 0; dt < 4; ++dt) {
                h4 ov;
#pragma unroll
                for (int r = 0; r < 4; ++r) ov[r] = (half_t)(o[dt][r] * inv);
                *(h4*)(p.y1 + row * D + 512 + hh * 64 + dt * 16 + 4 * lg) = ov;
            }
        }
        if (!hn) break;
        row = nrow; t = nt; rb = nrb; cnt = ncnt; buf ^= 1; qf[0] = nqf[0]; qf[1] = nqf[1];
    }
}

constexpr int NPH_L = 15;
constexpr int NPHASE = 1 + 2 * NPH_L;
constexpr int SMEM_BYTES = 144 * 1024;
static_assert(SMEM_BYTES >= ATT_BUF64 + 4 * 1024 * 4, "smem");
__device__ void run_phase(const P& p, int ph, char* smem) {
    const int vb = opaque_s(blockIdx.x), nvb = opaque_s(gridDim.x);
    if (ph == 0) {
        ph_bias_table(vb, nvb, p.rel_bias, p.bias_dist);
        ph_transpose_w(vb, nvb, smem, p.ev_w_in, D, EVEN_IN, p.wt_ev, EVEN_IN, p.norm_gains + 0 * D);
        ph_transpose_w(vb, nvb, smem, p.mix_w_out, D, D, p.wt_mix, D);
        for (int kh = 0; kh < 2; ++kh) ph_transpose_w(vb, nvb, smem, p.x_wq + (size_t)kh * 512 * 512, 512, 512, p.wt_q + (size_t)kh * 512 * 512, 512, p.norm_gains + 2 * D + kh * 512);
        ph_transpose_w(vb, nvb, smem, p.x_wkv, D, 1024, p.wt_kv, 1024);
        ph_transpose_w(vb, nvb, smem, p.x_wo, 512, D, p.wt_o, D);
        ph_transpose_w(vb, nvb, smem, p.b_w2, 64, 512, p.wt_w2, 512);
        ph_transpose_w(vb, nvb, smem, p.b_a2, 64, 512, p.wt_a2, 512);
        ph_transpose_w(vb, nvb, smem, p.b_g2, 128, 512, p.wt_g2, 512);
        ph_rmsnorm(vb, nvb, p.x, p.norm_gains, p.h, M, (half_t*)p.out + (size_t)M * D, p.xs2);
        ph_rmsnorm(vb, nvb, p.mem, p.mem_norm, p.memn, NB * MEM);
        return;
    }
    const int l = (ph - 1) / NPH_L, s = (ph - 1) % NPH_L;
    const float* g = p.norm_gains + (size_t)l * 6 * D;
    {
        const half_t *gA = nullptr, *gB = nullptr; int gN = 0, gK = 0, ng = 1;
        GemmEpi ge{}; ge.act = EPI_F16;
        const int fz = l * 3;
        half_t* xa = (half_t*)p.out; half_t* xb2 = (half_t*)p.out + (size_t)M * D; half_t* xc = (half_t*)(p.big + (size_t)M * DFF * 2);
        const int fi = fz + (s < 8 ? 0 : (s < 12 ? 1 : 2));
        const half_t* xres = (fi == 5) ? xc : ((fi & 1) ? xa : xb2);
        switch (s) {
        case 0: gA = xres; gB = (l == 0) ? p.wt_ev : p.wt_od; ge.O = p.p; gN = (l == 0) ? EVEN_IN : ODD_PAD; gK = D; ng = 2; ge.xs2_in = p.xs2; break;
        case 6: gA = (l == 0) ? p.y0 : p.y1; gB = p.wt_mix; gN = D; gK = D; ge.fused = 1; ge.g_post = g + 1 * D; ge.g_pre = g; ge.xs = p.xs + (size_t)(fz + 0) * 65536; ge.cnt = p.bar + 4096 + 64 * (fz + 0); break;
        case 8: gA = xres; gB = p.wt_q; ge.O = p.xq; gN = 1024; gK = 512; ge.xs2_in = p.xs2; break;
        case 10: gA = p.xo; gB = p.wt_o; gN = D; gK = 512; ge.fused = 1; ge.g_post = g + 3 * D; ge.g_pre = g; ge.xs = p.xs + (size_t)(fz + 1) * 65536; ge.cnt = p.bar + 4096 + 64 * (fz + 1); break;
        case 12: gA = xres; gB = p.wt_f1; ge.O = p.u; gN = DFF; gK = D; ge.act = EPI_RELU2; ge.xs2_in = p.xs2; break;
        case 13: gA = p.u; gB = p.wt_f2; gN = D; gK = DFF; ge.fused = 1; ge.g_post = g + 5 * D; ge.g_pre = (l == 0) ? g : (const float*)nullptr; ge.xs = p.xs + (size_t)(fz + 2) * 65536; ge.cnt = p.bar + 4096 + 64 * (fz + 2); break;
        default: ng = 0; break;
        }
        ge.ldc = gN; ge.hx = nullptr; ge.xs2_out = p.xs2;
        ge.x_in = xres; ge.x_out = (fi == 5) ? (void*)p.out : (fi == 4 ? (void*)xc : ((fi & 1) ? (void*)xb2 : (void*)xa)); ge.xin16 = 1; ge.xout16 = (fi != 5);
        for (int gi = 0; gi < ng; ++gi) {
            int gM = M, gvb = vb;
            if (gi == 1) { gA = p.memn; gB = p.wt_kv; ge.O = p.memkv; gN = 1024; gK = D; ge.ldc = 1024; ge.xs2_in = nullptr; gM = NB * MEM; gvb = (vb + nvb / 2) % nvb; }
            ph_gemm(ge, gvb, nvb, smem, gA, gB, gM, gN, gK, (s == 8) ? D : gK, (s == 8 && gi == 0) ? 2 : 0);
        }
    }
    switch (s) {
    case 0: break;
    case 1:
        if (l == 0) ph_rwkv_prep(vb, nvb, smem, p);
        else { ph_moba_kmean(vb, nvb, smem, p); ph_dsa_kin(vb, nvb, p); ph_transpose_w(vb, nvb, smem, p.ff_w2 + (size_t)DFF * D, DFF, D, p.wt_f2, D); }
        break;
    case 2:
        if (l == 0) ph_rwkv_pass1(vb, nvb, smem, p);
        else {
            if (vb < DSA_SCR_BLOCKS) ph_dsa_index(vb, nvb < DSA_SCR_BLOCKS ? nvb : DSA_SCR_BLOCKS, smem, p);
            ph_moba_gate(vb, nvb, smem, p);
        }
        break;
    case 3:
        if (l == 0) {
            if (nvb > NB * 16) { if (vb < NB * 8) rwkv_pass2_block<true>(p, vb); else ph_swa(vb - NB * 8, nvb - NB * 8, smem, p); }
            else { for (int u = vb; u < NB * 4; u += nvb) rwkv_pass2_block<false>(p, u); ph_swa(vb, nvb, smem, p); }
        } else { ph_moba(vb, nvb, smem, p); ph_dsa(vb, nvb, smem, p); }
        break;
    case 4: if (l == 0) ph_rwkv_pass3(vb, nvb, smem, p); break;
    case 5: break;
    case 6: break;
    case 7: break;
    case 8: break;
    case 9: ph_xattn(vb, nvb, smem, p); break;
    case 10: break;
    case 11: break;
    case 12:
        if (l == 0) {
            ph_transpose_w(vb, nvb, smem, p.od_w_in, D, ODD_IN, p.wt_od, ODD_PAD, p.norm_gains + 6 * D);
            ph_transpose_w(vb, nvb, smem, p.mix_w_out + (size_t)D * D, D, D, p.wt_mix, D);
            for (int kh = 0; kh < 2; ++kh) ph_transpose_w(vb, nvb, smem, p.x_wq + (size_t)D * 512 + (size_t)kh * 512 * 512, 512, 512, p.wt_q + (size_t)kh * 512 * 512, 512, p.norm_gains + 8 * D + kh * 512);
            ph_transpose_w(vb, nvb, smem, p.x_wkv + (size_t)D * 1024, D, 1024, p.wt_kv, 1024);
            ph_transpose_w(vb, nvb, smem, p.x_wo + (size_t)512 * D, 512, D, p.wt_o, D);
            ph_rmsnorm(vb, nvb, p.mem, p.mem_norm + D, p.memn, NB * MEM);
        }
        break;
    case 13:
        if (l == 0) ph_transpose_w(vb, nvb, smem, p.ff_w1 + (size_t)D * DFF, D, DFF, p.wt_f1, DFF, p.norm_gains + 10 * D);
        break;
    case 14: break;
    }
}
__device__ __forceinline__ bool phase_empty(int ph) { const int s_ = (ph - 1) % NPH_L; return ph >= 1 && (s_ == 5 || s_ == 7 || s_ == 11 || s_ == 14 || (ph >= 1 + NPH_L && s_ == 4)); }


#ifndef PROBE_REPS
#define PROBE_REPS(ph) 1
#endif
#ifndef CPU_EMU
#define XB_TMO      128
#define XB_XCNT(j)  (256  + 64 * (j))
#define XB_XSUB(j)  (1280 + 64 * (j))
#define XB_XGEN(j)  (2304 + 64 * (j))
#define XB_TOP      3328
#define XB_TOPGEN   3392
#define XCD_BAR_WORDS 3456
#define XB_SPIN_CAP (1u << 20)
#define LAS __attribute__((address_space(3)))
__device__ __forceinline__ unsigned xb_ld(unsigned* p)              { return __hip_atomic_load(p, __ATOMIC_RELAXED, __HIP_MEMORY_SCOPE_AGENT); }
__device__ __forceinline__ unsigned xb_add(unsigned* p, unsigned v) { return __hip_atomic_fetch_add(p, v, __ATOMIC_RELAXED, __HIP_MEMORY_SCOPE_AGENT); }
__device__ __forceinline__ unsigned xb_xcc_id() { return (unsigned)__builtin_amdgcn_s_getreg((3 << 11) | 20) & 0xFu; }
#define XB_SPIN(cond, bar) do { unsigned _sp = 0; while (cond) { __builtin_amdgcn_s_sleep(1); \
    if ((++_sp & 255u) == 0u) { if (xb_ld(&(bar)[XB_TMO])) break; if (_sp > XB_SPIN_CAP) { atomicAdd(&(bar)[XB_TMO], 1u); break; } } } } while (0)
struct XcdBarrier { unsigned* bar; unsigned x; volatile LAS unsigned* st; };
__device__ __forceinline__ XcdBarrier xcd_barrier_post(unsigned* bar, volatile LAS unsigned* st) {
    XcdBarrier b; b.bar = bar; b.x = xb_xcc_id(); b.st = st;
    if (threadIdx.x == 0) (void)xb_add(&bar[XB_XCNT(b.x)], 1u);
    return b;
}
__device__ __forceinline__ void xcd_barrier_complete(unsigned* bar, unsigned x, unsigned& nloc, unsigned& nx) {
    const unsigned G = gridDim.x * gridDim.y * gridDim.z;
    unsigned sum, cnt, mine, sp = 0u;
    for (;;) {
        sum = 0u; cnt = 0u; mine = 0u;
#pragma unroll
        for (unsigned j = 0; j < 16; ++j) { const unsigned c = xb_ld(&bar[XB_XCNT(j)]); sum += c; cnt += (c > 0u) ? 1u : 0u; mine = (j == x) ? c : mine; }
        if (sum == G) break;
        __builtin_amdgcn_s_sleep(1);
        if ((++sp & 255u) == 0u) { if (xb_ld(&bar[XB_TMO])) break; if (sp > XB_SPIN_CAP) { atomicAdd(&bar[XB_TMO], 1u); break; } }
    }
    nloc = mine > 0u ? mine : 1u; nx = cnt > 0u ? cnt : 1u;
}
__device__ __forceinline__ void xcd_barrier(const XcdBarrier& b) {
    asm volatile("s_waitcnt vmcnt(0)" ::: "memory");
    __syncthreads();
    if (threadIdx.x == 0) {
        unsigned* bar = b.bar;
        __builtin_amdgcn_s_waitcnt(0);
        unsigned nloc = b.st[0], nx = b.st[1];
        if (nloc == 0u) { xcd_barrier_complete(bar, b.x, nloc, nx); b.st[0] = nloc; b.st[1] = nx; }
        const unsigned old = xb_add(&bar[XB_XSUB(b.x)], 1u);
        const unsigned gen = old / nloc;
        if (old + 1u == (gen + 1u) * nloc) {
            __builtin_amdgcn_fence(__ATOMIC_RELEASE, "agent");
            asm volatile("s_waitcnt vmcnt(0)" ::: "memory");
            const unsigned og = xb_add(&bar[XB_TOP], 1u);
            const unsigned tg = og / nx;
            if (og + 1u == (tg + 1u) * nx) xb_add(&bar[XB_TOPGEN], 1u);
            else XB_SPIN(xb_ld(&bar[XB_TOPGEN]) == tg, bar);
            __builtin_amdgcn_fence(__ATOMIC_ACQUIRE, "agent");
            xb_add(&bar[XB_XGEN(b.x)], 1u);
            asm volatile("s_waitcnt vmcnt(0)" ::: "memory");
        } else {
            XB_SPIN(xb_ld(&bar[XB_XGEN(b.x)]) == gen, bar);
            __builtin_amdgcn_fence(__ATOMIC_ACQUIRE, "agent");
            asm volatile("s_waitcnt vmcnt(0)" ::: "memory");
        }
    }
    __syncthreads();
}
#ifndef CPU_EMU
#pragma clang attribute pop
#endif
__global__ void __launch_bounds__(512, 2) mega_kernel(P p) {
    extern __shared__ __attribute__((aligned(16))) char smem[];
    cooperative_groups::grid_group grid = cooperative_groups::this_grid();
    volatile LAS unsigned* st = (volatile LAS unsigned*)(smem + SMEM_BYTES);
    if (threadIdx.x == 0) { st[0] = 0u; st[1] = 0u; st[2] = 0u; st[3] = 0u; }
    __syncthreads();
    (void)xcd_barrier_post(p.bar, st);
    for (int ph = 0; ph < NPHASE; ++ph) {
        if (phase_empty(ph)) continue;
        for (int rep = 0; rep < PROBE_REPS(ph); ++rep) {
            run_phase(p, ph, smem);
            if (ph == 0) grid.sync();
            else if (ph + 1 < NPHASE || rep + 1 < PROBE_REPS(ph)) { XcdBarrier xb; xb.bar = p.bar; xb.x = xb_xcc_id(); xb.st = (volatile LAS unsigned*)(smem + SMEM_BYTES); xcd_barrier(xb); }
        }
    }
}
#else
static void emu_phase_kernel(P p, int ph) {
    static __attribute__((aligned(16))) char smem[SMEM_BYTES + 16];
    run_phase(p, ph, smem);
}
#endif

}

#ifdef CPU_EMU
static P g_dbgP;
static void (*g_dbg_hook)(int, int) = nullptr;
#endif

extern "C" void kernel_launch(void* const* d_in, const int* in_sizes, int n_in, void* d_out, int out_size, void* d_ws, size_t ws_size, hipStream_t stream) {
    (void)in_sizes; (void)n_in; (void)out_size;
    P p{};
    const float** ins = (const float**)&p;
    for (int i = 0; i < 26; ++i) ins[i] = (const float*)d_in[i];
    p.out = (float*)d_out;
    char* ws = (char*)d_ws; size_t off = 0;
    auto alloc = [&](size_t bytes) { void* r = ws + off; off += (bytes + 255) & ~(size_t)255; return r; };
    p.bar = (unsigned*)alloc((4096 + 64 * 6) * 4);
    p.xs = (float*)alloc((size_t)6 * 65536 * 4); p.xs2 = (float*)alloc((size_t)65536 * 4);
    p.wt_ev = (half_t*)alloc((size_t)EVEN_IN * D * 2); p.wt_od = p.wt_ev;
    p.wt_mix = (half_t*)alloc((size_t)D * D * 2); p.wt_q = (half_t*)alloc((size_t)512 * D * 2);
    p.wt_kv = (half_t*)alloc((size_t)1024 * D * 2); p.wt_o = (half_t*)alloc((size_t)D * 512 * 2);
    p.wt_f1 = (half_t*)alloc((size_t)DFF * D * 2); p.wt_f2 = (half_t*)alloc((size_t)D * DFF * 2);
    p.wt_w2 = (half_t*)alloc(512 * 64 * 2); p.wt_a2 = (half_t*)alloc(512 * 64 * 2); p.wt_g2 = (half_t*)alloc(512 * 128 * 2);
    p.memn = (half_t*)alloc((size_t)NB * MEM * D * 2); p.memkv = (half_t*)alloc((size_t)NB * MEM * 1024 * 2); p.memvT = (half_t*)alloc((size_t)NB * 512 * (MEM + 8) * 2);
    p.vT = (half_t*)alloc((size_t)NB * 128 * VTS * 2);
    p.kmean = (float*)alloc((size_t)NB * NBLK * 128 * 4); p.bias_dist = (float*)alloc(8 * 4096 * 4);
    p.mmask = (unsigned short*)alloc((size_t)M * 2 * 2);
    { char* xr = (char*)alloc((size_t)M * 512 * 2); p.rwY16 = (half_t*)xr; p.dsel = (unsigned short*)xr; p.kin = (half_t*)(xr + (size_t)M * 256 * 2); }
    p.h = (half_t*)alloc((size_t)M * D * 2); p.o = p.h; p.rwCS = (float*)p.h; p.kvd = p.h;
    p.rwMh = (half_t*)d_out;
    static_assert((size_t)NB * 8 * RNC * 8192 * 4 <= (size_t)M * D * 2, "chunk summaries must fit in R_h");
    static_assert((size_t)M * 256 * 2 + (size_t)M * 64 * 2 <= (size_t)M * 512 * 2, "dsel + kin fit");
    p.big = (char*)alloc(0);
    size_t bigsz = SZ_P0 + SZ_Y + 3 * SZ_C;
    if (SZ_P1 + SZ_Y + SZ_SCR > bigsz) bigsz = SZ_P1 + SZ_Y + SZ_SCR;
    if ((size_t)M * DFF * 2 > bigsz) bigsz = (size_t)M * DFF * 2;
    off += bigsz;
    if (off > ws_size) { fprintf(stderr, "workspace too small: need %zu have %zu\n", off, ws_size); }
    p.u = (half_t*)p.big; p.xq = (half_t*)p.big; p.xo = (half_t*)(p.big + 2 * SZ_C);
    p.p = (half_t*)p.big; p.y0 = (half_t*)(p.big + SZ_P0); p.y1 = (half_t*)(p.big + SZ_P1);
    p.rwL = (half_t*)(p.big + SZ_P0 + SZ_Y); p.rwA = p.rwL + (size_t)M * 512; p.rwG = p.rwA + (size_t)M * 512;
    p.scores = (float*)(p.big + SZ_P1 + SZ_Y);
#ifdef CPU_EMU
    for (int ph = 0; ph < NPHASE; ++ph) {
        emu::launch(dim3(8), dim3(NT), [=] { emu_phase_kernel(p, ph); });
        const int l = (ph - 1) / NPH_L, s = (ph - 1) % NPH_L;
        if (ph >= 1 && g_dbg_hook) {
            g_dbgP = p;
            if (s == 5) g_dbg_hook(l, 0);
            if (s == 7) g_dbg_hook(l, 1);
            if (s == 9) g_dbg_hook(l, 2);
            if (s == 11) g_dbg_hook(l, 3);
            if (s == 14) g_dbg_hook(l, 4);
        }
    }
#else
    static int grid_blocks = 0;
    if (!grid_blocks) {
        int dev = 0, cus = 0, per_cu = 0;
        hipGetDevice(&dev);
        hipDeviceGetAttribute(&cus, hipDeviceAttributeMultiprocessorCount, dev);
        hipFuncSetAttribute((const void*)mega_kernel, hipFuncAttributeMaxDynamicSharedMemorySize, SMEM_BYTES + 16);
        hipOccupancyMaxActiveBlocksPerMultiprocessor(&per_cu, mega_kernel, NT, SMEM_BYTES + 16);
        if (per_cu > 1) per_cu = 1;
        if (per_cu < 1) per_cu = 1;
        grid_blocks = cus * per_cu;
    }
    hipMemsetAsync(p.bar, 0, (4096 + 64 * 6) * 4, stream);
    void* args[] = {&p};
    hipError_t e = hipLaunchCooperativeKernel((void*)mega_kernel, dim3(grid_blocks), dim3(NT), args, SMEM_BYTES + 16, stream);
    if (e != hipSuccess) fprintf(stderr, "cooperative launch failed: %s (grid %d)\n", hipGetErrorString(e), grid_blocks);
#endif
}
```

```cpp
#ifndef CPU_EMU
#include <hip/hip_runtime.h>
#include <hip/hip_cooperative_groups.h>
#endif
#include <stdint.h>
#include <math.h>
#include <stdio.h>

#ifndef SEQ_T
#define SEQ_T 4096
#endif
#ifndef BATCH_B
#define BATCH_B 4
#endif

namespace {
#ifndef CPU_EMU
#pragma clang attribute push(__attribute__((always_inline)), apply_to = function)
#endif
constexpr int T = SEQ_T, NB = BATCH_B, M = NB * T, D = 1024;
constexpr int EVEN_IN = 2560, ODD_IN = 1732, ODD_PAD = 1792, DFF = 4096, MEM = 256;
constexpr int DSA_K = (T / 4 < 256) ? T / 4 : 256;
constexpr int NBLK = T / 256;
constexpr float EPS = 1e-6f;
constexpr int NT = 512, NW = 8;
constexpr int O_QC = 0, O_KC = 512, O_VC = 640, O_QD = 768, O_KD = 1280, O_VD = 1344, O_QI = 1408, O_KI = 1664, O_WI = 1728;
constexpr int E_QA = 0, E_KA = 512, E_VA = 640, E_PB = 768;

typedef _Float16 half_t;
typedef _Float16 h8 __attribute__((ext_vector_type(8)));
typedef _Float16 h4 __attribute__((ext_vector_type(4)));
typedef float f4 __attribute__((ext_vector_type(4)));
typedef unsigned u4 __attribute__((ext_vector_type(4)));

__device__ __forceinline__ f4 mfma16(h8 a, h8 b, f4 c) {
#ifdef CPU_EMU
    return emu_mfma_16x16x32_f16(a, b, c);
#else
    return __builtin_amdgcn_mfma_f32_16x16x32_f16(a, b, c, 0, 0, 0);
#endif
}
__device__ __forceinline__ f4 mfma4f32(float a, float b, f4 c) {
#ifdef CPU_EMU
    return emu_mfma_16x16x4_f32(a, b, c);
#else
    return __builtin_amdgcn_mfma_f32_16x16x4f32(a, b, c, 0, 0, 0);
#endif
}
__device__ __forceinline__ float bcast_lane(float v, int lane) {
#ifdef CPU_EMU
    return __shfl(v, lane);
#else
    return __builtin_bit_cast(float, __builtin_amdgcn_readlane(__builtin_bit_cast(int, v), lane));
#endif
}
__device__ __forceinline__ float fast_exp(float x) { return __expf(x); }
constexpr float LOG2E = 1.4426950408889634f;
__device__ __forceinline__ float fast_exp2(float x) {
#ifdef CPU_EMU
    return exp2f(x);
#else
    return __builtin_amdgcn_exp2f(x);
#endif
}
__device__ __forceinline__ float quad_bcast(float v, int i) {
#ifdef CPU_EMU
    return __shfl(v, ((int)(threadIdx.x & 63) & ~3) + i);
#else
    const int x = __builtin_bit_cast(int, v);
    switch (i) {
    case 0: return __builtin_bit_cast(float, __builtin_amdgcn_mov_dpp(x, 0x00, 0xF, 0xF, true));
    case 1: return __builtin_bit_cast(float, __builtin_amdgcn_mov_dpp(x, 0x55, 0xF, 0xF, true));
    case 2: return __builtin_bit_cast(float, __builtin_amdgcn_mov_dpp(x, 0xAA, 0xF, 0xF, true));
    default: return __builtin_bit_cast(float, __builtin_amdgcn_mov_dpp(x, 0xFF, 0xF, 0xF, true));
    }
#endif
}
#ifdef CPU_EMU
__device__ __forceinline__ float qb_mul(float vec, int i, float x) { return quad_bcast(vec, i) * x; }
__device__ __forceinline__ void qb_fmac(float& acc, float vec, int i, float x) { acc += quad_bcast(vec, i) * x; }
#else
#define QB_CASE(I) case I: asm("v_mul_f32_dpp %0, %1, %2 quad_perm:[" #I "," #I "," #I "," #I "] row_mask:0xf bank_mask:0xf" : "=v"(d) : "v"(vec), "v"(x)); break;
__device__ __forceinline__ float qb_mul(float vec, int i, float x) { float d; switch (i) { QB_CASE(0) QB_CASE(1) QB_CASE(2) default: asm("v_mul_f32_dpp %0, %1, %2 quad_perm:[3,3,3,3] row_mask:0xf bank_mask:0xf" : "=v"(d) : "v"(vec), "v"(x)); } return d; }
#undef QB_CASE
#define QB_CASE(I) case I: asm("v_fmac_f32_dpp %0, %1, %2 quad_perm:[" #I "," #I "," #I "," #I "] row_mask:0xf bank_mask:0xf" : "+v"(acc) : "v"(vec), "v"(x)); break;
__device__ __forceinline__ void qb_fmac(float& acc, float vec, int i, float x) { switch (i) { QB_CASE(0) QB_CASE(1) QB_CASE(2) default: asm("v_fmac_f32_dpp %0, %1, %2 quad_perm:[3,3,3,3] row_mask:0xf bank_mask:0xf" : "+v"(acc) : "v"(vec), "v"(x)); } }
#undef QB_CASE
#endif
#ifdef CPU_EMU
#define PIN(x) (void)0
#else
#define PIN(x) asm volatile("" : "+v"(x))
#endif
#ifdef CPU_EMU
#define TIDX ((int)threadIdx.x)
__device__ __forceinline__ int opaque_s(int v) { return v; }
#else
__device__ __forceinline__ int opaque_tid() { int t = threadIdx.x; asm volatile("" : "+v"(t)); return t; }
__device__ __forceinline__ int opaque_s(int v) { asm volatile("" : "+s"(v)); return v; }
#define TIDX opaque_tid()
#endif
#ifdef CPU_EMU
#define SCHED_FENCE() (void)0
#define WAVE_SYNC() emu::wave_barrier([] {})
#else
#define SCHED_FENCE() __builtin_amdgcn_sched_barrier(0)
#define WAVE_SYNC() (void)0
#endif
#ifdef CPU_EMU
#define SHFL_XOR(v, m) __shfl_xor(v, m)
#define SHFL_IDX(v, l) __shfl(v, l)
#define SHFL_DOWN(v, d) __shfl_down(v, d)
#else
template <class TT> __device__ __forceinline__ TT shfl_idx_raw(TT v, int src) { static_assert(sizeof(TT) == 4, ""); return __builtin_bit_cast(TT, __builtin_amdgcn_ds_bpermute(src << 2, __builtin_bit_cast(int, v))); }
#define SHFL_XOR(v, m) shfl_idx_raw(v, (TIDX & 63) ^ (m))
#define SHFL_IDX(v, l) shfl_idx_raw(v, (l))
#define SHFL_DOWN(v, d) shfl_idx_raw(v, ((TIDX & 63) + (d)) > 63 ? (TIDX & 63) : (TIDX & 63) + (d))
#endif
__device__ __forceinline__ float rows4_max(float v) {
#ifdef CPU_EMU
    v = fmaxf(v, __shfl_xor(v, 16)); return fmaxf(v, __shfl_xor(v, 32));
#else
    float xa = v, xb = v;
    asm volatile("s_nop 1\n\tv_permlane16_swap_b32 %0, %1" : "+v"(xa), "+v"(xb));
    const float m1 = fmaxf(xa, xb);
    float ya = m1, yb = m1;
    asm volatile("s_nop 1\n\tv_permlane32_swap_b32 %0, %1" : "+v"(ya), "+v"(yb));
    return fmaxf(ya, yb);
#endif
}
__device__ __forceinline__ float rows4_sum(float v) {
#ifdef CPU_EMU
    v += __shfl_xor(v, 16); return v + __shfl_xor(v, 32);
#else
    float xa = v, xb = v;
    asm volatile("s_nop 1\n\tv_permlane16_swap_b32 %0, %1" : "+v"(xa), "+v"(xb));
    const float s1 = xa + xb;
    float ya = s1, yb = s1;
    asm volatile("s_nop 1\n\tv_permlane32_swap_b32 %0, %1" : "+v"(ya), "+v"(yb));
    return ya + yb;
#endif
}

struct P {
    const float *x, *mem, *rel_bias, *norm_gains, *mix_w_out, *mem_norm, *x_wq, *x_wkv, *x_wo, *ff_w1, *ff_w2, *ev_w_in, *a_sinks, *b_mu, *b_w0,
        *b_w2, *b_a0, *b_a2, *b_g2, *b_k_k, *b_k_a, *b_r_k, *b_ln_w, *b_ln_b, *od_w_in, *d_kidx_norm;
    float* out;
    half_t *wt_ev, *wt_od, *wt_mix, *wt_q, *wt_kv, *wt_o, *wt_f1, *wt_f2, *wt_w2, *wt_a2, *wt_g2;
    half_t *h, *o, *p, *y0, *y1, *u, *xq, *xo, *memn, *memkv, *vT, *memvT, *kin, *rwL, *rwA, *rwG;
    float *rwCS, *kmean, *scores, *bias_dist; half_t* kvd; half_t* rwMh;
    half_t* rwY16;
    unsigned short *mmask, *dsel;
    char* big;
    unsigned* bar;
    float *xs, *xs2;
};
constexpr size_t SZ_P0 = (size_t)M * EVEN_IN * 2, SZ_P1 = (size_t)M * ODD_PAD * 2, SZ_Y = (size_t)M * D * 2, SZ_C = (size_t)M * 512 * 2;
constexpr int VTS = T + 64;
constexpr int SCS = T + 32;
constexpr int DSA_SCR_BLOCKS = 256;
constexpr size_t SZ_SCR = (size_t)DSA_SCR_BLOCKS * 16 * SCS * 4;

__device__ void ph_transpose_w(int vb, int nvb, char* smem_, const float* __restrict__ W, int K, int N, half_t* __restrict__ Wt, int Npad, const float* __restrict__ gk = nullptr, int ldt = 0) {
    if (ldt == 0) ldt = K;
    float (*tile)[65] = (float (*)[65])smem_;
    const int nk = K / 64, nn = Npad / 64, tid = TIDX;
    for (int t = vb; t < nk * nn; t += nvb) {
        const int k0 = (t % nk) * 64, n0 = (t / nk) * 64;
        __syncthreads();
        {
            const int r = tid >> 3, c = (tid & 7) * 8;
            f4 v0 = (f4){0.f, 0.f, 0.f, 0.f}, v1 = v0;
            if (n0 + c + 3 < N) v0 = *(const f4*)(W + (long)(k0 + r) * N + n0 + c);
            if (n0 + c + 7 < N) v1 = *(const f4*)(W + (long)(k0 + r) * N + n0 + c + 4);
            if (gk) { const float gg = gk[k0 + r]; v0 = v0 * gg; v1 = v1 * gg; }
#pragma unroll
            for (int j = 0; j < 4; ++j) { tile[r][c + j] = v0[j]; tile[r][c + 4 + j] = v1[j]; }
        }
        __syncthreads();
        {
            const int n = tid & 63, kc = (tid >> 6) * 8;
            h8 o;
#pragma unroll
            for (int j = 0; j < 8; ++j) o[j] = (half_t)tile[kc + j][n];
            *(h8*)(Wt + (long)(n0 + n) * ldt + k0 + kc) = o;
        }
    }
}

__device__ void wave_transpose_w(int wv, int nwv, float* tile_, const float* __restrict__ W, int K, int N, half_t* __restrict__ Wt, const float* __restrict__ gk) {
    float (*tile)[65] = (float (*)[65])tile_;
    const int lane = TIDX & 63, nk = K / 64, nn = N / 64;
    for (int t = wv; t < nk * nn; t += nwv) {
        const int k0 = (t % nk) * 64, n0 = (t / nk) * 64;
        WAVE_SYNC();
#pragma unroll 4
        for (int it = 0; it < 16; ++it) {
            const int r = it * 4 + (lane >> 4), c = (lane & 15) * 4;
            f4 v = *(const f4*)(W + (long)(k0 + r) * N + n0 + c);
            if (gk) v = v * gk[k0 + r];
            tile[r][c] = v[0]; tile[r][c + 1] = v[1]; tile[r][c + 2] = v[2]; tile[r][c + 3] = v[3];
        }
        WAVE_SYNC();
#pragma unroll 2
        for (int kc = 0; kc < 8; ++kc) {
            h8 o;
#pragma unroll
            for (int j = 0; j < 8; ++j) o[j] = (half_t)tile[kc * 8 + j][lane];
            *(h8*)(Wt + (long)(n0 + lane) * K + k0 + kc * 8) = o;
        }
    }
}
__device__ __forceinline__ int rel_bucket(int n) {
    if (n < 16) return n < 0 ? 0 : n;
    const int thr[15] = {21, 27, 35, 46, 59, 77, 99, 128, 166, 216, 280, 363, 470, 609, 790};
    int b = 16;
#pragma unroll
    for (int i = 0; i < 15; ++i) b += (n >= thr[i]) ? 1 : 0;
    return b;
}
__device__ void ph_bias_table(int vb, int nvb, const float* __restrict__ rel_bias, float* __restrict__ bias_dist) {
    for (int i = vb * NT + TIDX; i < 8 * 4096; i += nvb * NT) {
        int hh = i >> 12, d = i & 4095;
        bias_dist[i] = rel_bias[rel_bucket(d) * 8 + hh];
    }
}

__device__ __forceinline__ float wave_sum(float v) {
#ifdef CPU_EMU
#pragma unroll
    for (int o = 32; o >= 1; o >>= 1) v += SHFL_XOR(v, o);
    return v;
#else
#define WS_DPP(ctrl) asm("s_nop 1\n\tv_add_f32_dpp %0, %0, %0 " ctrl : "+v"(v))
    WS_DPP("quad_perm:[1,0,3,2] row_mask:0xf bank_mask:0xf"); WS_DPP("quad_perm:[2,3,0,1] row_mask:0xf bank_mask:0xf");
    WS_DPP("row_shr:4 row_mask:0xf bank_mask:0xf"); WS_DPP("row_shr:8 row_mask:0xf bank_mask:0xf");
    WS_DPP("row_bcast:15 row_mask:0xa bank_mask:0xf"); WS_DPP("row_bcast:31 row_mask:0xc bank_mask:0xf");
#undef WS_DPP
    return __builtin_bit_cast(float, __builtin_amdgcn_readlane(__builtin_bit_cast(int, v), 63));
#endif
}
__device__ __forceinline__ unsigned wave_prefix_sum(unsigned v) {
#ifdef CPU_EMU
    const int lane = (int)(threadIdx.x & 63);
#pragma unroll
    for (int o = 1; o < 64; o <<= 1) { const unsigned oth = __shfl_up(v, o); v += (lane >= o) ? oth : 0u; }
    return v;
#else
#define WP_DPP(ctrl, rmask) v += (unsigned)__builtin_amdgcn_update_dpp(0, (int)v, ctrl, rmask, 0xF, false)
    WP_DPP(0x111, 0xF); WP_DPP(0x112, 0xF); WP_DPP(0x114, 0xF); WP_DPP(0x118, 0xF); WP_DPP(0x142, 0xA); WP_DPP(0x143, 0xC);
#undef WP_DPP
    return v;
#endif
}
__device__ __forceinline__ unsigned bcast_u(unsigned v, int src) {
#ifdef CPU_EMU
    return __shfl(v, src);
#else
    return (unsigned)__builtin_amdgcn_readlane((int)v, __builtin_amdgcn_readfirstlane(src));
#endif
}
__device__ void ph_rmsnorm(int vb, int nvb, const float* __restrict__ x, const float* __restrict__ g, half_t* __restrict__ h, int rows, half_t* __restrict__ x16 = nullptr, float* __restrict__ xs2 = nullptr) {
    const int lane = TIDX & 63, w = TIDX >> 6;
    f4 nv[4];
    { const int r0 = vb * NW + w; const float* xr = x + (long)(r0 < rows ? r0 : 0) * D;
#pragma unroll
      for (int i = 0; i < 4; ++i) nv[i] = *(const f4*)(xr + i * 256 + lane * 4); }
    for (int r = vb * NW + w; r < rows; r += nvb * NW) {
        f4 v[4]; float ss = 0.f;
#pragma unroll
        for (int i = 0; i < 4; ++i) { v[i] = nv[i]; ss += v[i][0] * v[i][0] + v[i][1] * v[i][1] + v[i][2] * v[i][2] + v[i][3] * v[i][3]; }
        { const int rn = r + nvb * NW; const float* xr = x + (long)(rn < rows ? rn : r) * D;
#pragma unroll
          for (int i = 0; i < 4; ++i) nv[i] = *(const f4*)(xr + i * 256 + lane * 4); }
        ss = wave_sum(ss);
        const float rs = rsqrtf(ss * (1.0f / D) + EPS);
        if (xs2 && lane < 4) xs2[(size_t)(r >> 8) * 1024 + lane * 256 + (r & 255)] = (lane == 0) ? ss : 0.f;
#pragma unroll
        for (int i = 0; i < 4; ++i) {
            f4 gg = *(const f4*)(g + i * 256 + lane * 4); h4 o;
#pragma unroll
            for (int j = 0; j < 4; ++j) o[j] = (half_t)(v[i][j] * rs * gg[j]);
            if (x16) { h4 xo;
#pragma unroll
                for (int j = 0; j < 4; ++j) xo[j] = (half_t)v[i][j];
                *(h4*)(x16 + (long)r * D + i * 256 + lane * 4) = xo; }
            else *(h4*)(h + (long)r * D + i * 256 + lane * 4) = o;
        }
    }
}
__device__ void ph_post(int vb, int nvb, const float* x, const half_t* o, const float* __restrict__ gpost, const float* __restrict__ gpre,
                                              float* xout, half_t* h, int rows) {
    const int lane = TIDX & 63, w = TIDX >> 6;
    for (int r = vb * NW + w; r < rows; r += nvb * NW) {
        const half_t* orow = o + (long)r * D; const float* xr = x + (long)r * D;
        f4 v[4]; float ss = 0.f;
#pragma unroll
        for (int i = 0; i < 4; ++i) { h4 t4 = *(const h4*)(orow + i * 256 + lane * 4); v[i] = (f4){(float)t4[0], (float)t4[1], (float)t4[2], (float)t4[3]}; ss += v[i][0] * v[i][0] + v[i][1] * v[i][1] + v[i][2] * v[i][2] + v[i][3] * v[i][3]; }
        ss = wave_sum(ss);
        const float rs = rsqrtf(ss * (1.0f / D) + EPS);
        float s2 = 0.f;
#pragma unroll
        for (int i = 0; i < 4; ++i) {
            f4 gg = *(const f4*)(gpost + i * 256 + lane * 4); f4 xv = *(const f4*)(xr + i * 256 + lane * 4);
#pragma unroll
            for (int j = 0; j < 4; ++j) { v[i][j] = xv[j] + v[i][j] * rs * gg[j]; s2 += v[i][j] * v[i][j]; }
            *(f4*)(xout + (long)r * D + i * 256 + lane * 4) = v[i];
        }
        if (gpre) {
            s2 = wave_sum(s2);
            const float r2 = rsqrtf(s2 * (1.0f / D) + EPS);
#pragma unroll
            for (int i = 0; i < 4; ++i) {
                f4 gg = *(const f4*)(gpre + i * 256 + lane * 4); h4 ov;
#pragma unroll
                for (int j = 0; j < 4; ++j) ov[j] = (half_t)(v[i][j] * r2 * gg[j]);
                *(h4*)(h + (long)r * D + i * 256 + lane * 4) = ov;
            }
        }
    }
}

constexpr int EPI_F16 = 0, EPI_RELU2 = 2;
struct GemmEpi {
    half_t* O; int ldc; int act; int fused;
    const float* xs2_in; const void* x_in; void* x_out; int xin16, xout16; const float* g_post; const float* g_pre; half_t* hx; float* xs; unsigned* cnt; float* xs2_out;
};
#ifdef CPU_EMU
__device__ void ph_gemm(const GemmEpi& ge, int vb, int nvb, char* smem_, const half_t* A, const half_t* Bt, int Mr, int N, int K, int lda, int nsplit) {
    (void)smem_; (void)nvb;
    if (vb != 0 || TIDX != 0) return;
    std::vector<float> Af((size_t)Mr * K), Bf((size_t)N * K), Cf((size_t)Mr * N);
    std::vector<float> Af2((size_t)Mr * K);
    for (int i = 0; i < Mr; ++i) for (int k = 0; k < K; ++k) { Af[(size_t)i * K + k] = (float)A[(size_t)i * lda + k]; if (nsplit > 0) Af2[(size_t)i * K + k] = (float)A[(size_t)i * lda + K + k]; }
    for (size_t i = 0; i < Bf.size(); ++i) Bf[i] = (float)Bt[i];
    for (int i0 = 0; i0 < Mr; i0 += 32) for (int j0 = 0; j0 < N; j0 += 32) {
        float acc[32][32] = {};
        for (int k0 = 0; k0 < K; k0 += 256)
            for (int i = 0; i < 32; ++i) for (int j = 0; j < 32; ++j) {
                const float* a = ((nsplit > 0 && j0 >= nsplit * 256) ? &Af2[(size_t)(i0 + i) * K + k0] : &Af[(size_t)(i0 + i) * K + k0]); const float* bq = &Bf[(size_t)(j0 + j) * K + k0];
                float sacc = 0.f; for (int k = 0; k < 256 && k0 + k < K; ++k) sacc += a[k] * bq[k];
                acc[i][j] += sacc;
            }
        for (int i = 0; i < 32; ++i) for (int j = 0; j < 32; ++j) Cf[(size_t)(i0 + i) * N + j0 + j] = acc[i][j];
    }
    for (int i = 0; i < Mr; ++i) {
        float* c = &Cf[(size_t)i * N];
        if (!ge.fused) {
            float rs = 1.f;
            if (ge.xs2_in) { const float* q = ge.xs2_in + (size_t)(i / 256) * 1024 + (i % 256); rs = rsqrtf(((q[0] + q[256]) + (q[512] + q[768])) * (1.0f / 1024.0f) + EPS); }
            for (int j = 0; j < N; ++j) { float t = c[j] * rs; if (ge.act == EPI_RELU2) { t = fmaxf(t, 0.f); t = t * t; } ge.O[(size_t)i * ge.ldc + j] = (half_t)t; }
        } else {
            float ss = 0.f; for (int j = 0; j < N; ++j) ss += c[j] * c[j];
            const float rs = rsqrtf(ss * (1.0f / 1024.0f) + EPS);
            float part[4] = {0.f, 0.f, 0.f, 0.f};
            for (int j = 0; j < N; ++j) { const float xi = (float)((const half_t*)ge.x_in)[(size_t)i * D + j]; float xn = xi + c[j] * rs * ge.g_post[j];
                if (ge.xout16) { const half_t hq = (half_t)xn; ((half_t*)ge.x_out)[(size_t)i * D + j] = hq; xn = (float)hq; } else ((float*)ge.x_out)[(size_t)i * D + j] = xn;
                part[j >> 8] += xn * xn; }
            if (ge.g_pre) for (int q = 0; q < 4; ++q) ge.xs2_out[((size_t)(i / 256) * 4 + q) * 256 + (i % 256)] = part[q];
        }
    }
}
#else
namespace pg8 {
#define PG8_LAS __attribute__((address_space(3)))
constexpr int BM = 256, BK = 64, HALF = 128, HTB = HALF * BK * 2, NXCD = 8, WGM = 4;
__device__ __forceinline__ int lds_byte(int r, int c) { const int st = (r >> 4) * 2 + (c >> 5), rr = r & 15, cc = c & 31, ob = rr * 64 + cc * 2; return st * 1024 + (ob ^ (((ob >> 9) & 1) << 5)); }
__device__ __forceinline__ void stage_rc(int b, int& R, int& C) { const int st = b / 1024, sb = b % 1024, swz = sb ^ (((sb >> 9) & 1) << 5); R = (st >> 1) * 16 + swz / 64; C = (st & 1) * 32 + (swz % 64) / 2; }
__device__ __forceinline__ int perm32(int rho) { const int n = rho >> 4, i = rho & 15; return 8 * (i >> 2) + 4 * n + (i & 3); }
struct Unit { int pm, pn; };
struct Gemm { const half_t* A; const half_t* Bt; int M, N, K; int lda; int nsplit; };
struct StaticOrder {
    int nM, nN, nwg, G, c;
    __device__ void init(int M_, int N_, int G_, int c_) { nM = M_ / BM; nN = N_ / BM; nwg = nM * nN; G = G_; c = c_; }
    __device__ bool next(int i, Unit& u) const {
        const long L = (long)i * G + c; if (L >= nwg) return false;
        int wgid = (int)L; { const int q = nwg / NXCD, r = nwg % NXCD, xcd = wgid % NXCD, off = wgid / NXCD; wgid = (xcd < r ? xcd * (q + 1) : r * (q + 1) + (xcd - r) * q) + off; }
        const int nig = WGM * nN, gid = wgid / nig, fm = gid * WGM, gsz = (nM - fm) < WGM ? (nM - fm) : WGM;
        u.pm = fm + ((wgid % nig) % gsz); u.pn = (wgid % nig) / gsz; return true;
    }
};
struct EpiH {
    half_t* O; int ldc; int ACT; int fused;
    const float* xs2_in;
    const void* x_in; void* x_out; int xin16, xout16; const float* g_post; const float* g_pre; half_t* hx; float* xs; unsigned* cnt; float* xs2_out;
    __device__ __forceinline__ void operator()(const f4 (&acc)[2][2][4][2], const Unit& u, int wr, int wc, int fr, int fq, PG8_LAS half_t* stg) const {
        const int lane = fq * 16 + fr, sr = lane >> 2, sc = (lane & 3) * 8;
        const int row0 = u.pm * BM + wr * 64 + sr, col0 = u.pn * BM + wc * 32 + sc;
        float rsv[2][4];
#pragma unroll
        for (int ai = 0; ai < 2; ++ai)
#pragma unroll
            for (int m = 0; m < 4; ++m) rsv[ai][m] = 1.f;
        if (xs2_in) {
            float t4[2][4][4];
#pragma unroll
            for (int ai = 0; ai < 2; ++ai)
#pragma unroll
                for (int m = 0; m < 4; ++m) { const float* q = xs2_in + (size_t)u.pm * 1024 + (wr * 64 + fr + ai * HALF + m * 16); t4[ai][m][0] = q[0]; t4[ai][m][1] = q[256]; t4[ai][m][2] = q[512]; t4[ai][m][3] = q[768]; }
#pragma unroll
            for (int ai = 0; ai < 2; ++ai)
#pragma unroll
                for (int m = 0; m < 4; ++m) rsv[ai][m] = rsqrtf(((t4[ai][m][0] + t4[ai][m][1]) + (t4[ai][m][2] + t4[ai][m][3])) * (1.0f / 1024.0f) + EPS);
        }
#pragma unroll
        for (int ai = 0; ai < 2; ++ai)
#pragma unroll
            for (int m = 0; m < 4; ++m) { half_t* rowp = O + (size_t)(row0 + ai * HALF + m * 16) * ldc + col0;
                const float rs = rsv[ai][m];
#pragma unroll
                for (int bj = 0; bj < 2; ++bj) { h8 o;
#pragma unroll
                    for (int n = 0; n < 2; ++n)
#pragma unroll
                        for (int r = 0; r < 4; ++r) { float t = acc[ai][bj][m][n][r] * rs; if (ACT == EPI_RELU2) { t = fmaxf(t, 0.f); t = t * t; } o[n * 4 + r] = (half_t)t; }
                    *(PG8_LAS h8*)(stg + fr * 40 + fq * 8) = o;
                    asm volatile("s_waitcnt lgkmcnt(0)" ::: "memory");
                    const h8 t8 = *(const PG8_LAS h8*)(stg + sr * 40 + sc);
                    asm volatile("s_waitcnt lgkmcnt(0)" ::: "memory");
                    *(h8*)(rowp + bj * HALF) = t8; } }
    }
    __device__ __forceinline__ void run_fused(const f4 (&acc)[2][2][4][2], const Unit& u, int wr, int wc, int fr, int fq, float* red, int tid) const {
        const int col0 = u.pn * BM + wc * 32 + 8 * fq;
        h8 xin[2][4][2]; f4 gpv[2][2];
#pragma unroll
        for (int bj = 0; bj < 2; ++bj) { gpv[bj][0] = *(const f4*)(g_post + col0 + bj * HALF); gpv[bj][1] = *(const f4*)(g_post + col0 + bj * HALF + 4); }
#pragma unroll
        for (int ai = 0; ai < 2; ++ai)
#pragma unroll
            for (int m = 0; m < 4; ++m)
#pragma unroll
                for (int bj = 0; bj < 2; ++bj)
                    xin[ai][m][bj] = *(const h8*)((const half_t*)x_in + ((size_t)u.pm * BM + ai * HALF + wr * 64 + m * 16 + fr) * D + col0 + bj * HALF);
#pragma unroll
        for (int ai = 0; ai < 2; ++ai)
#pragma unroll
            for (int m = 0; m < 4; ++m) {
                float sq = 0.f;
#pragma unroll
                for (int bj = 0; bj < 2; ++bj)
#pragma unroll
                    for (int n = 0; n < 2; ++n) { const f4 v = acc[ai][bj][m][n]; sq += (v[0] * v[0] + v[1] * v[1]) + (v[2] * v[2] + v[3] * v[3]); }
                sq = rows4_sum(sq);
                if (fq == 0) red[(ai * HALF + wr * 64 + m * 16 + fr) * 4 + wc] = sq;
            }
        __syncthreads();
        if (tid < 256) { const float tot = (red[tid * 4] + red[tid * 4 + 1]) + (red[tid * 4 + 2] + red[tid * 4 + 3]);
            __hip_atomic_store(xs + ((size_t)u.pm * 4 + u.pn) * 256 + tid, tot, __ATOMIC_RELAXED, __HIP_MEMORY_SCOPE_AGENT); }
        asm volatile("s_waitcnt vmcnt(0)" ::: "memory");
        __syncthreads();
        if (tid == 0) {
            (void)__hip_atomic_fetch_add(cnt + u.pm, 1u, __ATOMIC_RELAXED, __HIP_MEMORY_SCOPE_AGENT);
            unsigned spins = 0;
            while (__hip_atomic_load(cnt + u.pm, __ATOMIC_RELAXED, __HIP_MEMORY_SCOPE_AGENT) < 4u) { __builtin_amdgcn_s_sleep(2); if (++spins > (1u << 22)) break; }
            __builtin_amdgcn_fence(__ATOMIC_ACQUIRE, "agent");
            asm volatile("s_waitcnt vmcnt(0)" ::: "memory");
        }
        __syncthreads();
        float* rsl = red + 1024;
        if (tid < 256) { const float* q = xs + (size_t)u.pm * 1024 + tid;
            const float t0 = __hip_atomic_load(q, __ATOMIC_RELAXED, __HIP_MEMORY_SCOPE_AGENT), t1 = __hip_atomic_load(q + 256, __ATOMIC_RELAXED, __HIP_MEMORY_SCOPE_AGENT),
                        t2 = __hip_atomic_load(q + 512, __ATOMIC_RELAXED, __HIP_MEMORY_SCOPE_AGENT), t3 = __hip_atomic_load(q + 768, __ATOMIC_RELAXED, __HIP_MEMORY_SCOPE_AGENT);
            rsl[tid] = rsqrtf(((t0 + t1) + (t2 + t3)) * (1.0f / 1024.0f) + EPS); }
        __syncthreads();
#pragma unroll
        for (int ai = 0; ai < 2; ++ai)
#pragma unroll
            for (int m = 0; m < 4; ++m) {
                const int rl = ai * HALF + wr * 64 + m * 16 + fr; const size_t row = (size_t)u.pm * BM + rl;
                const float rs = rsl[rl];
                float s2 = 0.f;
#pragma unroll
                for (int bj = 0; bj < 2; ++bj) {
                    const int c = col0 + bj * HALF; h8 xo;
                    const h8 xv = xin[ai][m][bj];
                    const f4 gp0 = gpv[bj][0], gp1 = gpv[bj][1];
                    f4 xn0, xn1;
#pragma unroll
                    for (int r = 0; r < 4; ++r) { xn0[r] = (float)xv[r] + acc[ai][bj][m][0][r] * rs * gp0[r]; xn1[r] = (float)xv[4 + r] + acc[ai][bj][m][1][r] * rs * gp1[r]; }
                    if (xout16) {
#pragma unroll
                        for (int r = 0; r < 4; ++r) { xo[r] = (half_t)xn0[r]; xo[4 + r] = (half_t)xn1[r]; xn0[r] = (float)xo[r]; xn1[r] = (float)xo[4 + r]; }
                        *(h8*)((half_t*)x_out + row * D + c) = xo;
                    } else { *(f4*)((float*)x_out + row * D + c) = xn0; *(f4*)((float*)x_out + row * D + c + 4) = xn1; }
#pragma unroll
                    for (int r = 0; r < 4; ++r) s2 += xn0[r] * xn0[r] + xn1[r] * xn1[r];
                }
                s2 = rows4_sum(s2);
                if (fq == 0) red[rl * 4 + wc] = s2;
            }
        __syncthreads();
        if (g_pre && tid < 256) xs2_out[((size_t)u.pm * 4 + u.pn) * 256 + tid] = (red[tid * 4] + red[tid * 4 + 1]) + (red[tid * 4 + 2] + red[tid * 4 + 3]);
    }
};
template <class Epi>
__device__ __forceinline__ void gemm_phase(PG8_LAS unsigned char* lds, const Gemm g, const StaticOrder& S, const Epi& E) {
    const int tid = TIDX, wid = __builtin_amdgcn_readfirstlane(tid >> 6), lane = tid & 63, wr = wid >> 2, wc = wid & 3, fr = lane & 15, fq = lane >> 4;
    const int K = g.K, nt = K / BK, lda = g.lda;
    unsigned voffA[2], voffB[2];
#pragma unroll
    for (int i = 0; i < 2; ++i) { int R, C; stage_rc(tid * 16 + i * 8192, R, C); const int Rb = (R & ~31) + perm32(R & 31);
        voffA[i] = (unsigned)(R * lda + C) * 2u; voffB[i] = (unsigned)(Rb * K + C) * 2u; }
    const size_t kstep = (size_t)(BK * 2);
    const size_t hstepA = (size_t)HALF * lda * 2, hstepB = (size_t)HALF * K * 2;
    const size_t tstepA = 2 * hstepA, tstepB = 2 * hstepB, ksplit = (size_t)K * 2;
    const int nsplit = g.nsplit > 0 ? g.nsplit : 0x7fffffff;
    const unsigned ldsw = (unsigned)wid * 1024u;
    const int aoff = lds_byte(wr * 64 + fr, fq * 8), boff = lds_byte(wc * 32 + fr, fq * 8);
#define PG8_SA(b, h) (((b) * 2 + (h)) * HTB)
#define PG8_SB(b, h) ((4 + (b) * 2 + (h)) * HTB)
#define PG8_STAGE(bufoff, gbase, voff) do { _Pragma("unroll") for (int _i = 0; _i < 2; ++_i) \
        __builtin_amdgcn_global_load_lds((const unsigned*)((const char*)(gbase) + (voff)[_i]), (PG8_LAS unsigned*)(lds + (bufoff) + ldsw + _i * 8192), 16, 0, 0); } while (0)
#define PG8_LDA(dst, b, h) do { _Pragma("unroll") for (int m = 0; m < 4; ++m) _Pragma("unroll") for (int k = 0; k < 2; ++k) dst[m][k] = *(const PG8_LAS h8*)(lds + PG8_SA(b, h) + aoff + m * 2048 + k * 1024); } while (0)
#define PG8_LDB(dst, b, h) do { _Pragma("unroll") for (int n = 0; n < 2; ++n) _Pragma("unroll") for (int k = 0; k < 2; ++k) dst[n][k] = *(const PG8_LAS h8*)(lds + PG8_SB(b, h) + boff + n * 2048 + k * 1024); } while (0)
#define PG8_MMA(ai, bj, At, Bt) do { __builtin_amdgcn_s_setprio(1); _Pragma("unroll") for (int m = 0; m < 4; ++m) _Pragma("unroll") for (int n = 0; n < 2; ++n) _Pragma("unroll") for (int k = 0; k < 2; ++k) \
        acc[ai][bj][m][n] = __builtin_amdgcn_mfma_f32_16x16x32_f16(Bt[n][k], At[m][k], acc[ai][bj][m][n], 0, 0, 0); __builtin_amdgcn_s_setprio(0); } while (0)
#define PG8_WAIT_V(n) asm volatile("s_waitcnt vmcnt(" #n ")" ::: "memory")
#define PG8_WAIT_L(n) asm volatile("s_waitcnt lgkmcnt(" #n ")" ::: "memory")
#define PG8_BAR __builtin_amdgcn_s_barrier()
#define PG8_SCHED __builtin_amdgcn_sched_barrier(0)
    Unit cur, nxt; int ui = 0;
    if (!S.next(0, cur)) return;
    f4 acc[2][2][4][2];
#pragma unroll
    for (int a = 0; a < 2; ++a)
#pragma unroll
        for (int b = 0; b < 2; ++b)
#pragma unroll
            for (int m = 0; m < 4; ++m)
#pragma unroll
                for (int n = 0; n < 2; ++n) acc[a][b][m][n] = (f4){0.f, 0.f, 0.f, 0.f};
    h8 At[4][2], B0[2][2], B1[2][2];
    const char* cA = (const char*)g.A + (size_t)cur.pm * tstepA + (cur.pn >= nsplit ? ksplit : 0); const char* cB = (const char*)g.Bt + (size_t)cur.pn * tstepB;
    PG8_STAGE(PG8_SB(0, 0), cB, voffB); PG8_STAGE(PG8_SB(0, 1), cB + hstepB, voffB); PG8_STAGE(PG8_SA(0, 0), cA, voffA); PG8_STAGE(PG8_SA(0, 1), cA + hstepA, voffA);
    if (wr == 1) PG8_BAR;
    PG8_WAIT_V(2); PG8_BAR;
    PG8_STAGE(PG8_SB(1, 0), cB + kstep, voffB); PG8_STAGE(PG8_SA(1, 0), cA + kstep, voffA); PG8_STAGE(PG8_SB(1, 1), cB + hstepB + kstep, voffB);
    PG8_WAIT_V(6); PG8_BAR;
    for (;;) {
        const bool has_next = S.next(ui + 1, nxt);
        const char* nA = has_next ? (const char*)g.A + (size_t)nxt.pm * tstepA + (nxt.pn >= nsplit ? ksplit : 0) : cA; const char* nB = has_next ? (const char*)g.Bt + (size_t)nxt.pn * tstepB : cB;
        for (int t = 0; t < nt; t += 2) {
            const bool last = (t == nt - 2);
            const char* a1 = cA + (size_t)(t + 1) * kstep;
            const char* a2 = last ? nA : cA + (size_t)(t + 2) * kstep; const char* b2 = last ? nB : cB + (size_t)(t + 2) * kstep;
            const char* a3 = a2 + kstep; const char* b3 = b2 + kstep;
            PG8_LDB(B0, 0, 0); PG8_LDB(B1, 0, 1); PG8_SCHED; PG8_LDA(At, 0, 0); PG8_STAGE(PG8_SA(1, 1), a1 + hstepA, voffA);
            PG8_WAIT_V(8); PG8_WAIT_L(0); PG8_BAR; PG8_MMA(0, 0, At, B0); PG8_MMA(0, 1, At, B1); PG8_BAR; PG8_SCHED;
            PG8_LDA(At, 0, 1); PG8_STAGE(PG8_SB(0, 0), b2, voffB); PG8_STAGE(PG8_SB(0, 1), b2 + hstepB, voffB); PG8_STAGE(PG8_SA(0, 0), a2, voffA);
            PG8_WAIT_V(8); PG8_WAIT_L(0); PG8_BAR; PG8_MMA(1, 0, At, B0); PG8_MMA(1, 1, At, B1); PG8_BAR; PG8_SCHED;
            PG8_LDB(B0, 1, 0); PG8_LDB(B1, 1, 1); PG8_SCHED; PG8_LDA(At, 1, 0); PG8_STAGE(PG8_SA(0, 1), a2 + hstepA, voffA);
            PG8_WAIT_V(8); PG8_WAIT_L(0); PG8_BAR; PG8_MMA(0, 0, At, B0); PG8_MMA(0, 1, At, B1); PG8_BAR; PG8_SCHED;
            PG8_LDA(At, 1, 1); PG8_STAGE(PG8_SB(1, 0), b3, voffB); PG8_STAGE(PG8_SB(1, 1), b3 + hstepB, voffB); PG8_STAGE(PG8_SA(1, 0), a3, voffA);
            PG8_WAIT_V(8); PG8_WAIT_L(0); PG8_BAR; PG8_MMA(1, 0, At, B0); PG8_MMA(1, 1, At, B1); PG8_BAR; PG8_SCHED;
        }
        if (wr == 0) PG8_BAR;
        if (!E.fused) E(acc, cur, wr, wc, fr, fq, (PG8_LAS half_t*)(lds + 131072) + wid * 640);
        if (!has_next) break;
#pragma unroll
        for (int a = 0; a < 2; ++a)
#pragma unroll
            for (int b = 0; b < 2; ++b)
#pragma unroll
                for (int m = 0; m < 4; ++m)
#pragma unroll
                    for (int n = 0; n < 2; ++n) acc[a][b][m][n] = (f4){0.f, 0.f, 0.f, 0.f};
        cur = nxt; cA = nA; cB = nB; ++ui;
        if (wr == 1) PG8_BAR;
    }
    PG8_WAIT_V(0);
    PG8_BAR;
    if (E.fused) E.run_fused(acc, cur, wr, wc, fr, fq, (float*)(unsigned char*)lds, tid);
#undef PG8_SA
#undef PG8_SB
#undef PG8_STAGE
#undef PG8_LDA
#undef PG8_LDB
#undef PG8_MMA
#undef PG8_WAIT_V
#undef PG8_WAIT_L
#undef PG8_BAR
#undef PG8_SCHED
}
}
__device__ __forceinline__ void ph_gemm(const GemmEpi& ge, int vb, int nvb, char* smem_, const half_t* A, const half_t* Bt, int Mr, int N, int K, int lda, int nsplit) {
    pg8::Gemm g{A, Bt, Mr, N, K, lda, nsplit}; pg8::StaticOrder S; S.init(Mr, N, nvb, vb);
    pg8::EpiH E{ge.O, ge.ldc, ge.act, ge.fused, ge.xs2_in, ge.x_in, ge.x_out, ge.xin16, ge.xout16, ge.g_post, ge.g_pre, ge.hx, ge.xs, ge.cnt, ge.xs2_out};
    __syncthreads();
    pg8::gemm_phase((__attribute__((address_space(3))) unsigned char*)smem_, g, S, E);
    __syncthreads();
}
#endif

__device__ void ph_transpose_cols(int vb, int nvb, char* smem_, const half_t* __restrict__ src, int ld, int c0, int nc, int tt, int nb, half_t* __restrict__ dst, int dld) {
    half_t (*tile)[66] = (half_t (*)[66])smem_;
    const int ntt = tt / 64, ncc = nc / 64, total = nb * ntt * ncc;
    for (int t = vb; t < total; t += nvb) {
        const int b = t / (ntt * ncc), r = t % (ntt * ncc), t0 = (r / ncc) * 64, cc0 = (r % ncc) * 64;
        __syncthreads();
        for (int i = TIDX; i < 4096; i += NT) { int rr = i >> 6, c = i & 63; tile[rr][c] = src[((long)b * tt + t0 + rr) * ld + c0 + cc0 + c]; }
        __syncthreads();
        for (int i = TIDX; i < 4096; i += NT) { int c = i >> 6, rr = i & 63; dst[((long)b * nc + cc0 + c) * dld + t0 + rr] = tile[rr][c]; }
    }
}

template <int DT>
__device__ __forceinline__ void attn_step(f4 s0, f4 s1, const h8 (&vf)[DT], float& m, float& l, f4 (&o)[DT]) {
    float mx = fmaxf(fmaxf(fmaxf(s0[0], s0[1]), fmaxf(s0[2], s0[3])), fmaxf(fmaxf(s1[0], s1[1]), fmaxf(s1[2], s1[3])));
    mx = rows4_max(mx);
    const float mn = fmaxf(m, mx);
    const float ms = (mn == -INFINITY) ? 0.f : mn;
    if (__ballot(mn > m)) {
        const float alpha = fast_exp2(m - ms);
        l = l * alpha;
#pragma unroll
        for (int dt = 0; dt < DT; ++dt) o[dt] = o[dt] * alpha;
    }
    h8 pb; float ps = 0.f;
#pragma unroll
    for (int r = 0; r < 4; ++r) { float p0 = fast_exp2(s0[r] - ms), p1 = fast_exp2(s1[r] - ms); ps += p0 + p1; pb[r] = (half_t)p0; pb[4 + r] = (half_t)p1; }
    l += ps;
#pragma unroll
    for (int dt = 0; dt < DT; ++dt) o[dt] = mfma16(vf[dt], pb, o[dt]);
    m = mn;
}
template <int DT>
__device__ __forceinline__ void attn_step64(const f4 (&sv)[4], const h8 (&vf0)[DT], const h8 (&vf1)[DT], float& m, float& l, f4 (&o)[DT], bool sel = true) {
    float mx = fmaxf(fmaxf(fmaxf(sv[0][0], sv[0][1]), fmaxf(sv[0][2], sv[0][3])), fmaxf(fmaxf(sv[1][0], sv[1][1]), fmaxf(sv[1][2], sv[1][3])));
    mx = fmaxf(mx, fmaxf(fmaxf(fmaxf(sv[2][0], sv[2][1]), fmaxf(sv[2][2], sv[2][3])), fmaxf(fmaxf(sv[3][0], sv[3][1]), fmaxf(sv[3][2], sv[3][3]))));
    mx = sel ? mx : -INFINITY;
    mx = rows4_max(mx);
    const float mn = fmaxf(m, mx);
    const float ms0 = (mn == -INFINITY) ? 0.f : mn;
    if (__ballot(mn > m)) {
        const float alpha = fast_exp2(m - ms0);
        l = l * alpha;
#pragma unroll
        for (int dt = 0; dt < DT; ++dt) o[dt] = o[dt] * alpha;
    }
    const float ms = sel ? ms0 : INFINITY;
    h8 pb0, pb1; float ps = 0.f;
#pragma unroll
    for (int r = 0; r < 4; ++r) {
        const float p0 = fast_exp2(sv[0][r] - ms), p1 = fast_exp2(sv[1][r] - ms), p2 = fast_exp2(sv[2][r] - ms), p3 = fast_exp2(sv[3][r] - ms);
        ps += (p0 + p1) + (p2 + p3); pb0[r] = (half_t)p0; pb0[4 + r] = (half_t)p1; pb1[r] = (half_t)p2; pb1[4 + r] = (half_t)p3;
    }
    l += ps;
#pragma unroll
    for (int dt = 0; dt < DT; ++dt) { o[dt] = mfma16(vf0[dt], pb0, o[dt]); o[dt] = mfma16(vf1[dt], pb1, o[dt]); }
    m = mn;
}
template <int KC, int DT> struct StepRegs { h8 kf[2][KC]; h8 vf[DT]; float bv[8]; int s0; int aux; };
template <int KC, int DT, class MASK>
__device__ __forceinline__ void attn_compute(const h8 (&qf)[KC], StepRegs<KC, DT>& cur, float& m, float& l, f4 (&o)[DT], MASK&& mask) {
    f4 sv[2];
#pragma unroll
    for (int tl = 0; tl < 2; ++tl) {
        f4 acc = (f4){0.f, 0.f, 0.f, 0.f};
#pragma unroll
        for (int c = 0; c < KC; ++c) acc = mfma16(cur.kf[tl][c], qf[c], acc);
        sv[tl] = acc;
    }
    mask(cur, sv[0], sv[1]);
    attn_step<DT>(sv[0], sv[1], cur.vf, m, l, o);
}
template <int KC, int DT, class NEXT, class LOAD, class MASK>
__device__ __forceinline__ void attn_loop(const h8 (&qf)[KC], float& m, float& l, f4 (&o)[DT], NEXT&& next, LOAD&& load, MASK&& mask) {
    StepRegs<KC, DT> A, B;
    A.s0 = 0; A.aux = 0;
    if (!next(A)) return;
    load(A);
    for (;;) {
        B.s0 = A.s0; B.aux = A.aux;
        bool hn = next(B);
        load(B);
        SCHED_FENCE();
        attn_compute<KC, DT>(qf, A, m, l, o, mask);
        if (!hn) break;
        A.s0 = B.s0; A.aux = B.aux;
        hn = next(A);
        load(A);
        SCHED_FENCE();
        attn_compute<KC, DT>(qf, B, m, l, o, mask);
        if (!hn) break;
    }
}
__device__ __forceinline__ h8 ld_vt8(const half_t* vr, int k0, int k1) {
    const h4 a = *(const h4*)(vr + k0), bb = *(const h4*)(vr + k1);
    return (h8){a[0], a[1], a[2], a[3], bb[0], bb[1], bb[2], bb[3]};
}

__device__ __forceinline__ h4 lds_tr_read(const half_t* addr) {
#ifdef CPU_EMU
    return emu_ds_read_tr16(addr);
#else
    typedef short v4i16 __attribute__((ext_vector_type(4)));
    const v4i16 r = __builtin_amdgcn_ds_read_tr16_b64_v4i16((__attribute__((address_space(3))) v4i16*)addr);
    return __builtin_bit_cast(h4, r);
#endif
}
template <int DH, int TK = 64> struct ATile {
    static constexpr int KC = DH / 32, DT = DH / 16, KS = DH + 8, VS = DH + 8, KB = TK * KS * 2, VB = TK * VS * 2, BUF = KB + VB;
    static constexpr int NKL = TK * (DH / 8) / NT, NVL = NKL;
    h8 kr[NKL], vr[NVL];
};
template <int DH, bool DBUF, int TK, class NEXT, class KSRC, class VSRC, class MASK, class SKIP>
__device__ __forceinline__ void attn_block(char* smem, const h8 (&qf)[DH / 32], float& m, float& l, f4 (&o)[DH / 16], NEXT&& next, KSRC&& ksrc, VSRC&& vsrc, MASK&& mask, SKIP&& skip) {
    typedef ATile<DH, TK> TL;
    const int tid = TIDX, lane = tid & 63, lr = lane & 15, lg = lane >> 4;
    TL R;
    auto issue = [&](int s0) {
#pragma unroll
        for (int i = 0; i < TL::NKL; ++i) { const int q = tid + i * NT, row = q / (DH / 8), ch = q % (DH / 8); R.kr[i] = *(const h8*)ksrc(s0, row, ch); }
#pragma unroll
        for (int i = 0; i < TL::NVL; ++i) { const int q = tid + i * NT, row = q / (DH / 8), ch = q % (DH / 8); R.vr[i] = *(const h8*)vsrc(s0, row, ch); }
    };
    auto stash = [&](char* buf) {
        half_t* K = (half_t*)buf; half_t* V = (half_t*)(buf + TL::KB);
#pragma unroll
        for (int i = 0; i < TL::NKL; ++i) { const int q = tid + i * NT, row = q / (DH / 8), ch = q % (DH / 8); *(h8*)(K + row * TL::KS + ch * 8) = R.kr[i]; }
#pragma unroll
        for (int i = 0; i < TL::NVL; ++i) { const int q = tid + i * NT, row = q / (DH / 8), ch = q % (DH / 8); *(h8*)(V + row * TL::VS + ch * 8) = R.vr[i]; }
    };
    auto compute = [&](const char* buf, int s0t) {
#pragma unroll 1
      for (int sub = 0; sub < TK / 64; ++sub) {
        const int s0 = s0t + sub * 64;
        if (skip(s0)) continue;
        const half_t* K = (const half_t*)buf + sub * 64 * TL::KS; const half_t* V = (const half_t*)(buf + TL::KB) + sub * 64 * TL::VS;
        f4 sv[4];
#pragma unroll
        for (int kt = 0; kt < 4; ++kt) {
            f4 acc = (f4){0.f, 0.f, 0.f, 0.f};
#pragma unroll
            for (int c = 0; c < TL::KC; ++c) acc = mfma16(*(const h8*)(K + (kt * 16 + lr) * TL::KS + c * 32 + lg * 8), qf[c], acc);
            sv[kt] = acc;
        }
        const bool qsel = mask(s0, sv);
        if (DH == 64) {
            h8 vf0[TL::DT], vf1[TL::DT];
#pragma unroll
            for (int dt = 0; dt < TL::DT; ++dt) {
                const half_t* vrow = V + (4 * lg + (lr >> 2)) * TL::VS + dt * 16 + 4 * (lr & 3);
                const h4 x0 = lds_tr_read(vrow), y0 = lds_tr_read(vrow + 16 * TL::VS), x1 = lds_tr_read(vrow + 32 * TL::VS), y1 = lds_tr_read(vrow + 48 * TL::VS);
                vf0[dt] = (h8){x0[0], x0[1], x0[2], x0[3], y0[0], y0[1], y0[2], y0[3]};
                vf1[dt] = (h8){x1[0], x1[1], x1[2], x1[3], y1[0], y1[1], y1[2], y1[3]};
            }
            attn_step64<TL::DT>(sv, vf0, vf1, m, l, o, qsel);
        } else {
#pragma unroll
            for (int hs = 0; hs < 2; ++hs) {
                h8 vf[TL::DT];
#pragma unroll
                for (int dt = 0; dt < TL::DT; ++dt) {
                    const half_t* vrow = V + (hs * 32 + 4 * lg + (lr >> 2)) * TL::VS + dt * 16 + 4 * (lr & 3);
                    const h4 x = lds_tr_read(vrow), y = lds_tr_read(vrow + 16 * TL::VS);
                    vf[dt] = (h8){x[0], x[1], x[2], x[3], y[0], y[1], y[2], y[3]};
                }
                attn_step<TL::DT>(sv[hs * 2], sv[hs * 2 + 1], vf, m, l, o);
            }
        }
      }
    };
    int s0 = 0, s1 = 0;
    __syncthreads();
    if (!next(s0)) return;
    issue(s0);
    if (DBUF) {
        stash(smem); __syncthreads();
        int cur = 0;
        for (;;) {
            const bool has = next(s1);
            if (has) issue(s1);
            compute(smem + cur * TL::BUF, s0);
            if (!has) break;
            stash(smem + (cur ^ 1) * TL::BUF);
            __syncthreads();
            cur ^= 1; s0 = s1;
        }
    } else {
        for (;;) {
            stash(smem); __syncthreads();
            const bool has = next(s1);
            if (has) issue(s1);
            compute(smem, s0);
            if (!has) break;
            __syncthreads();
            s0 = s1;
        }
    }
}
__device__ __forceinline__ int snake_unit(int i, int vb, int nvb) { return i * nvb + ((i & 1) ? nvb - 1 - vb : vb); }
constexpr int ATT_BUF64 = 2 * ATile<64>::BUF;

__device__ void ph_swa(int vb, int nvb, char* smem, const P& p, unsigned* ctr = nullptr) {
    const int tid = TIDX, w = tid >> 6, lane = tid & 63, lr = lane & 15, lg = lane >> 4, hd = w & 3, qt = w >> 2;
    const half_t* pp = p.p; const int ld = EVEN_IN;
    constexpr int SWN = 384;
    float* rt = (float*)(smem + ATT_BUF64) + w * SWN;
    const int nunits = NB * 2 * (T / 32);
    int lastkv = -1;
    int* uslot = (int*)(smem + ATT_BUF64 + NW * SWN * 4);
    for (int i = 0;; ++i) {
        int u = snake_unit(i, vb, nvb);
        if (ctr) {
            __syncthreads();
            if (tid == 0) *uslot = (int)atomicAdd(ctr, 1u);
            __syncthreads();
            u = *uslot;
        }
        if (u >= nunits) break;
        const int kvh = u & 1, b = (u >> 1) % NB, t0g = ((u >> 1) / NB) * 32, t0 = t0g + qt * 16, hh = kvh * 4 + hd, tq = t0 + lr;
        if (kvh != lastkv) { WAVE_SYNC(); for (int j = lane; j < SWN; j += 64) { const int d = 255 - j; rt[j] = (d >= 0 && d < 128) ? p.bias_dist[hh * 4096 + d] * LOG2E : -INFINITY; } lastkv = kvh; WAVE_SYNC(); }
        h8 qf[2];
#pragma unroll
        for (int c = 0; c < 2; ++c) qf[c] = *(const h8*)(pp + ((long)b * T + tq) * ld + E_QA + hh * 64 + c * 32 + lg * 8);
        float m = -INFINITY, l = 0.f; f4 o[4];
#pragma unroll
        for (int q = 0; q < 4; ++q) o[q] = (f4){0.f, 0.f, 0.f, 0.f};
        int nx = (t0g - 127 < 0 ? 0 : t0g - 127) & ~63;
        attn_block<64, true, 64>(smem, qf, m, l, o,
            [&](int& s0) { if (nx > t0g + 31) return false; s0 = nx; nx += 64; return true; },
            [&](int s0, int row, int ch) { return pp + ((long)b * T + s0 + row) * ld + E_KA + kvh * 64 + ch * 8; },
            [&](int s0, int row, int ch) { return pp + ((long)b * T + s0 + row) * ld + E_VA + kvh * 64 + ch * 8; },
            [&](int s0, f4 (&a)[4]) {
                const float* rb = rt + (255 - (tq - s0 - 4 * lg));
#pragma unroll
                for (int kt = 0; kt < 4; ++kt)
#pragma unroll
                    for (int q = 0; q < 4; ++q) a[kt][q] = a[kt][q] * (0.125f * LOG2E) + rb[kt * 16 + q];
                return true;
            },
            [&](int s0) { return s0 > t0 + 15 || s0 + 63 < t0 - 127; });
        l = rows4_sum(l);
        const float sink = p.a_sinks[hh] * LOG2E;
        const float mf = fmaxf(m, sink), sc = fast_exp2(m - mf), inv = sc / (l * sc + fast_exp2(sink - mf));
#pragma unroll
        for (int dt = 0; dt < 4; ++dt) {
            h4 ov;
#pragma unroll
            for (int r = 0; r < 4; ++r) ov[r] = (half_t)(o[dt][r] * inv);
            *(h4*)(p.y0 + ((long)b * T + tq) * D + hh * 64 + dt * 16 + 4 * lg) = ov;
        }
    }
}

__device__ void ph_xattn(int vb, int nvb, char* smem, const P& p) {
    const int tid = TIDX, w = tid >> 6, lane = tid & 63, lr = lane & 15, lg = lane >> 4;
    const int nunits = NB * 4 * (T / 128);
    for (int u = vb; u < nunits; u += nvb) {
        const int hx = u & 3, b = (u >> 2) % NB, t0 = ((u >> 2) / NB) * 128 + w * 16, tq = t0 + lr;
        h8 qf[4];
#pragma unroll
        for (int c = 0; c < 4; ++c) { const half_t* qp = p.xq + ((long)b * T + tq) * 1024 + hx * 128 + c * 32 + lg * 8; qf[c] = *(const h8*)qp + *(const h8*)(qp + 512); }
        float m = -INFINITY, l = 0.f; f4 o[8];
#pragma unroll
        for (int q = 0; q < 8; ++q) o[q] = (f4){0.f, 0.f, 0.f, 0.f};
        const float scale = 0.08838834764831845f;
        int nx = 0;
        attn_block<128, true, 64>(smem, qf, m, l, o,
            [&](int& s0) { if (nx >= MEM) return false; s0 = nx; nx += 64; return true; },
            [&](int s0, int row, int ch) { return p.memkv + ((long)b * MEM + s0 + row) * 1024 + hx * 128 + ch * 8; },
            [&](int s0, int row, int ch) { return p.memkv + ((long)b * MEM + s0 + row) * 1024 + 512 + hx * 128 + ch * 8; },
            [&](int s0, f4 (&a)[4]) { (void)s0; a[0] = a[0] * (scale * LOG2E); a[1] = a[1] * (scale * LOG2E); a[2] = a[2] * (scale * LOG2E); a[3] = a[3] * (scale * LOG2E); return true; },
            [&](int) { return false; });
        l = rows4_sum(l);
        const float inv = 1.0f / l;
#pragma unroll
        for (int dt = 0; dt < 8; ++dt) {
            h4 ov;
#pragma unroll
            for (int r = 0; r < 4; ++r) ov[r] = (half_t)(o[dt][r] * inv);
            *(h4*)(p.xo + ((long)b * T + tq) * 512 + hx * 128 + dt * 16 + 4 * lg) = ov;
        }
    }
}

__device__ __forceinline__ float tshift(const half_t* pp, long row, int tt, int col, float mu) {
    const float cur = (float)pp[row * EVEN_IN + E_PB + col];
    float prv = (float)pp[(row > 0 ? row - 1 : 0) * EVEN_IN + E_PB + col];
    PIN(prv);
    prv = tt > 0 ? prv : 0.f;
    return cur + (prv - cur) * mu;
}
__device__ void ph_rwkv_prep(int vb, int nvb, char* smem_, const P& p) {
    const int tid = TIDX, lane = tid & 63, w = tid >> 6, lr = lane & 15, lg = lane >> 4;
    constexpr int WS = 72, GS = 136;
    half_t* sw = (half_t*)smem_; half_t* sa = sw + 256 * WS; half_t* sg = sa + 256 * WS;
    const int nh = vb & 1, ngrp = nvb >> 1;
    if (ngrp == 0) return;
    __syncthreads();
    {
        h8 tw[4], ta[4], tg[8];
#pragma unroll
        for (int k = 0; k < 4; ++k) { const int i = tid + k * NT, r = i >> 3, c8 = (i & 7) * 8; tw[k] = *(const h8*)(p.wt_w2 + (nh * 256 + r) * 64 + c8); ta[k] = *(const h8*)(p.wt_a2 + (nh * 256 + r) * 64 + c8); }
#pragma unroll
        for (int k = 0; k < 8; ++k) { const int i = tid + k * NT, r = i >> 4, c8 = (i & 15) * 8; tg[k] = *(const h8*)(p.wt_g2 + (nh * 256 + r) * 128 + c8); }
#pragma unroll
        for (int k = 0; k < 4; ++k) { const int i = tid + k * NT, r = i >> 3, c8 = (i & 7) * 8; *(h8*)(sw + r * WS + c8) = tw[k]; *(h8*)(sa + r * WS + c8) = ta[k]; }
#pragma unroll
        for (int k = 0; k < 8; ++k) { const int i = tid + k * NT, r = i >> 4, c8 = (i & 15) * 8; *(h8*)(sg + r * GS + c8) = tg[k]; }
    }
    __syncthreads();
    for (int tile = (vb >> 1) * NW + w; tile < M / 16; tile += ngrp * NW) {
        const long row = (long)tile * 16 + lr; const int tt = (int)(row % T);
        const half_t* cur = p.p + row * EVEN_IN + E_PB + 1536; const half_t* prv = p.p + (row > 0 ? row - 1 : 0) * EVEN_IN + E_PB + 1536;
        h8 xf[8];
#pragma unroll
        for (int c = 0; c < 8; ++c) {
            const h8 cv = *(const h8*)(cur + c * 32 + lg * 8); h8 pv = *(const h8*)(prv + c * 32 + lg * 8);
            const f4 m0 = *(const f4*)(p.b_mu + 1536 + c * 32 + lg * 8), m1 = *(const f4*)(p.b_mu + 1536 + c * 32 + lg * 8 + 4);
#pragma unroll
            for (int j = 0; j < 8; ++j) {
                const float cf = (float)cv[j], pf = tt > 0 ? (float)pv[j] : 0.f, mu = j < 4 ? m0[j] : m1[j - 4];
                const float v = cf + (pf - cf) * mu;
                xf[c][j] = (half_t)(c < 2 ? tanhf(v) : (c < 4 ? v : 1.0f / (1.0f + __expf(-v))));
            }
        }
        for (int nt = 0; nt < 16; ++nt) {
            const int n = nt * 16 + lr;
            f4 aw = (f4){0.f, 0.f, 0.f, 0.f}, aa = aw, ag = aw;
#pragma unroll
            for (int c = 0; c < 2; ++c) { aw = mfma16(*(const h8*)(sw + n * WS + c * 32 + lg * 8), xf[c], aw); aa = mfma16(*(const h8*)(sa + n * WS + c * 32 + lg * 8), xf[2 + c], aa); }
#pragma unroll
            for (int c = 0; c < 4; ++c) ag = mfma16(*(const h8*)(sg + n * GS + c * 32 + lg * 8), xf[4 + c], ag);
            const int ch = nh * 256 + nt * 16 + 4 * lg;
            const f4 w0 = *(const f4*)(p.b_w0 + ch), a0 = *(const f4*)(p.b_a0 + ch);
            h4 ol, oa, og;
#pragma unroll
            for (int r = 0; r < 4; ++r) {
                const float wr = w0[r] + aw[r];
                const float sp = fmaxf(-wr, 0.f) + __logf(1.0f + __expf(-fabsf(wr)));
                ol[r] = (half_t)__expf(-sp - 0.5f);
                oa[r] = (half_t)(1.0f / (1.0f + __expf(-(a0[r] + aa[r]))));
                og[r] = (half_t)ag[r];
            }
            *(h4*)(p.rwL + row * 512 + ch) = ol; *(h4*)(p.rwA + row * 512 + ch) = oa; *(h4*)(p.rwG + row * 512 + ch) = og;
        }
    }
}
constexpr int RC = 128, RNC = T / RC, RSC = 8;
constexpr int RWS = 72, RWM = 16 * RWS;
#ifdef CPU_EMU
#define RW_FENCE() WAVE_SYNC()
#else
#define RW_FENCE() asm volatile("s_waitcnt lgkmcnt(0)" ::: "memory")
#endif
__device__ __forceinline__ h4 cvt4(f4 v) { return (h4){(half_t)v[0], (half_t)v[1], (half_t)v[2], (half_t)v[3]}; }
__device__ __forceinline__ h8 cat8(h4 a, h4 b) { return (h8){a[0], a[1], a[2], a[3], b[0], b[1], b[2], b[3]}; }
__device__ __forceinline__ h8 op4(f4 v) { const h4 a = cvt4(v); const half_t z = (half_t)0.f; return (h8){a[0], a[1], a[2], a[3], z, z, z, z}; }
#ifdef CPU_EMU
typedef volatile unsigned* hs_ptr;
__device__ __forceinline__ void hs_wait(hs_ptr w, unsigned target) { while (*w < target) emu::yield(); }
__device__ __forceinline__ void hs_post(hs_ptr w, unsigned v) { WAVE_SYNC(); *w = v; }
#else
typedef volatile __attribute__((address_space(3))) unsigned* hs_ptr;
__device__ __forceinline__ void hs_wait(hs_ptr w, unsigned target) { while (*w < target) __builtin_amdgcn_s_sleep(1); asm volatile("" ::: "memory"); }
__device__ __forceinline__ void hs_post(hs_ptr w, unsigned v) { asm volatile("s_waitcnt lgkmcnt(0)" ::: "memory"); *w = v; }
#endif
template <int MODE>
__device__ void rwkv_chunk_wave(const P& p, int u, int c, float* vecs  , float* vown, hs_ptr hs, unsigned& seq) {
    const int lane = TIDX & 63, lr = lane & 15, lg = lane >> 4, b = u >> 3, hh = u & 7, ch = hh * 64 + lane;
    const long row0 = (long)b * T + (long)c * RC;
    float* cs = p.rwCS + (size_t)(u * RNC + c) * 8192;
    half_t* MA = (half_t*)vecs; half_t* MR = MA + RWM; half_t* MB = MR + RWM; half_t* MK = MB + RWM; half_t* MV = MK + RWM; half_t* MG = MV + RWM;
    half_t* MG2 = MG + RWM;
    half_t* KR = (MODE == 2) ? MG2 + RWM : MR;
    float* fvec = (float*)(MG + (MODE == 2 ? 3 : 1) * RWM); float* bon = fvec + 64;
    f4 St[4][4];
    if (MODE == 2 && c > 0) {
        const float* sp = cs - 8192 + 4096;
#pragma unroll
        for (int kt = 0; kt < 4; ++kt)
#pragma unroll
            for (int vt = 0; vt < 4; ++vt) St[kt][vt] = *(const f4*)(sp + ((kt * 4 + vt) * 64 + lane) * 4);
    } else {
#pragma unroll
        for (int kt = 0; kt < 4; ++kt)
#pragma unroll
            for (int vt = 0; vt < 4; ++vt)
#pragma unroll
                for (int r = 0; r < 4; ++r) St[kt][vt][r] = (MODE == 1 && (16 * kt + 4 * lg + r) == (16 * vt + lr)) ? 1.f : 0.f;
    }
    const float mur = p.b_mu[ch], muk = p.b_mu[512 + ch], muv = p.b_mu[1024 + ch], kkw = p.b_k_k[ch], kaw = p.b_k_a[ch];
    float pr = 0.f, pk = 0.f, pv = 0.f;
    if (c > 0) { const half_t* q = p.p + (row0 - 1) * EVEN_IN + E_PB + ch; pr = (float)q[0]; pk = (float)q[512]; pv = (float)q[1024]; }
    constexpr int NRAW = (MODE == 2) ? 6 : 5;
    const float rkw = p.b_r_k[ch], lnw = p.b_ln_w[ch], lnb = p.b_ln_b[ch];
    half_t rawA[RSC][NRAW], rawB[RSC][NRAW];
    auto load_group = [&](half_t (&raw)[RSC][NRAW], int g) {
#pragma unroll
        for (int s2 = 0; s2 < RSC; ++s2) {
            const long row = row0 + g * RSC + s2;
            const half_t* q = p.p + row * EVEN_IN + E_PB + ch;
            raw[s2][0] = q[0]; raw[s2][1] = q[512]; raw[s2][2] = q[1024];
            raw[s2][3] = p.rwL[row * 512 + ch]; raw[s2][4] = p.rwA[row * 512 + ch];
            if (MODE == 2) raw[s2][5] = p.rwG[row * 512 + ch];
        }
    };
    const f4 Z4 = (f4){0.f, 0.f, 0.f, 0.f};
    const h4 ZH = (h4){(half_t)0.f, (half_t)0.f, (half_t)0.f, (half_t)0.f};
    float carry = 0.f;
    if (MODE != 1) load_group(rawA, 0);
    for (int sc = 0; sc < RC / 16; ++sc) {
      if (MODE != 1) {
        load_group(rawB, 2 * sc + 1);
        if (MODE == 0 && seq > 0) hs_wait(hs + 1, seq);
        float Gm = 0.f;
#pragma unroll
        for (int s2 = 0; s2 < RSC; ++s2) Gm += (float)rawA[s2][3];
        Gm *= LOG2E;
        float G = 0.f, erp = fast_exp2(Gm);
        auto expand = [&](half_t (&cur)[RSC][NRAW], int t0) {
#pragma unroll
            for (int s2 = 0; s2 < RSC; ++s2) {
                const int t = t0 + s2;
                const float cr = (float)cur[s2][0], ck = (float)cur[s2][1], cv = (float)cur[s2][2];
                const float r = cr + (pr - cr) * mur, k0 = ck + (pk - ck) * muk, v = cv + (pv - cv) * muv;
                pr = cr; pk = ck; pv = cv;
                const float a = (float)cur[s2][4];
                G += (float)cur[s2][3] * LOG2E;
                const float er = fast_exp2(Gm - G), ek = fast_exp2(G - Gm);
                float kk = k0 * kkw;
                if (MODE != 1) KR[t * RWS + lane] = (half_t)kk;
                const float kp = k0 * (1.0f + (a - 1.0f) * kaw);
                MA[t * RWS + lane] = (half_t)(-kk * erp);
                MB[t * RWS + lane] = (half_t)(kk * a * ek);
                if (MODE != 1) { MK[t * RWS + lane] = (half_t)(kp * ek); MV[t * RWS + lane] = (half_t)v; }
                if (MODE == 2) {
                    const float bs = wave_sum(r * kp * rkw), gg = (float)cur[s2][NRAW - 1];
                    MR[t * RWS + lane] = (half_t)(r * er); MG[t * RWS + lane] = (half_t)(gg * lnw); MG2[t * RWS + lane] = (half_t)(gg * (lnb + bs * v));
                }
                erp = er;
            }
        };
        expand(rawA, 0);
        if (sc + 1 < RC / 16) load_group(rawA, 2 * sc + 2);
        expand(rawB, 8);
        fvec[lane] = fast_exp2(carry - Gm); carry = Gm - G;
        RW_FENCE();
        if (MODE == 0) hs_post(hs, seq + 1);
      } else hs_wait(hs, seq + 1);
        h8 SO[2][4];
        {
            h4 sh[4][4];
#pragma unroll
            for (int kt = 0; kt < 4; ++kt) {
                const f4 fv = *(const f4*)(fvec + 16 * kt + 4 * lg);
#pragma unroll
                for (int vt = 0; vt < 4; ++vt) { St[kt][vt] = St[kt][vt] * fv; sh[kt][vt] = cvt4(St[kt][vt]); }
            }
#pragma unroll
            for (int kk = 0; kk < 2; ++kk)
#pragma unroll
                for (int vt = 0; vt < 4; ++vt) SO[kk][vt] = cat8(sh[2 * kk][vt], sh[2 * kk + 1][vt]);
        }
        auto rowop = [&](const half_t* M, int kk) { const half_t* q = M + lr * RWS + 32 * kk + 4 * lg; return cat8(*(const h4*)q, *(const h4*)(q + 16)); };
        auto mm2 = [&](const h8 (&x)[2], const h8 (&y)[2]) { return mfma16(x[1], y[1], mfma16(x[0], y[0], Z4)); };
        h8 AO[2] = {rowop(MA, 0), rowop(MA, 1)}, BO[2] = {rowop(MB, 0), rowop(MB, 1)};
        f4 rnq;
        {
            const h8 KRO[2] = {rowop(KR, 0), rowop(KR, 1)};
            const f4 Gd = mm2(KRO, KRO);
            const int e = lr & 3;
            float ss = (e == 0) ? Gd[0] : ((e == 1) ? Gd[1] : ((e == 2) ? Gd[2] : Gd[3]));
            ss = (lg == (lr >> 2)) ? ss : 0.f;
            ss = rows4_sum(ss);
            const float rn = rsqrtf(fmaxf(ss, 1e-24f));
            const half_t rh = (half_t)rn;
            const h8 r8 = (h8){rh, rh, rh, rh, rh, rh, rh, rh};
            AO[0] = AO[0] * r8; AO[1] = AO[1] * r8; BO[0] = BO[0] * r8; BO[1] = BO[1] * r8;
            if (lg == 0) bon[lr] = rn;
            RW_FENCE();
            rnq = *(const f4*)(bon + 4 * lg);
        }
        h8 KO[2] = {AO[0], AO[1]}, RO[2] = {AO[0], AO[1]};
        if (MODE != 1) { KO[0] = rowop(MK, 0); KO[1] = rowop(MK, 1); }
        if (MODE == 2) { RO[0] = rowop(MR, 0); RO[1] = rowop(MR, 1); }
        f4 Nn = mm2(AO, BO), X = mm2(BO, AO), TT;
#pragma unroll
        for (int r = 0; r < 4; ++r) {
            const int row = 4 * lg + r;
            Nn[r] = (lr < row) ? Nn[r] : 0.f; X[r] = (row < lr) ? X[r] : 0.f;
            TT[r] = X[r] + ((row == lr) ? 1.f : 0.f);
        }
        {
            const h8 oN = op4(Nn), oX = op4(X);
            const f4 X2 = mfma16(oN, oX, Z4), N2 = mfma16(oX, oN, Z4);
            const h8 oN2 = op4(N2), oX2 = op4(X2);
            TT = mfma16(oN2, op4(TT), TT);
            const f4 X4 = mfma16(oN2, oX2, Z4), N4 = mfma16(oX2, oN2, Z4);
            const h8 oN4 = op4(N4), oX4 = op4(X4);
            TT = mfma16(oN4, op4(TT), TT);
            const f4 N8 = mfma16(oX4, oN4, Z4);
            TT = mfma16(op4(N8), op4(TT), TT);
        }
        h8 oAK = AO[0], oAR = AO[0];
        if (MODE != 1) {
            f4 AK = mm2(KO, AO);
#pragma unroll
            for (int r = 0; r < 4; ++r) AK[r] = (4 * lg + r < lr) ? AK[r] : 0.f;
            oAK = op4(AK);
        }
        if (MODE == 2) {
            f4 RB = mm2(BO, RO), RK = mm2(KO, RO);
#pragma unroll
            for (int r = 0; r < 4; ++r) { const bool keep = 4 * lg + r <= lr; RB[r] = keep ? RB[r] : 0.f; RK[r] = keep ? RK[r] : 0.f; }
            oAR = cat8(cvt4(RB), cvt4(RK));
        }
        const int troff = (4 * lg + (lr >> 2)) * RWS + 4 * (lr & 3);
        h8 ZV[4];
        {
            const h8 oTT = op4(TT);
#pragma unroll
            for (int vt = 0; vt < 4; ++vt) {
                h4 vx = ZH;
                if (MODE != 1) vx = lds_tr_read(MV + troff + 16 * vt);
                f4 rhs = mfma16(AO[1], SO[1][vt], mfma16(AO[0], SO[0][vt], Z4));
                if (MODE != 1) rhs = mfma16(oAK, cat8(vx, ZH), rhs);
                const f4 z = mfma16(oTT, op4(rhs), Z4);
                ZV[vt] = cat8(cvt4(z), vx);
            }
        }
        if (MODE == 2) {
            f4 Y[4];
#pragma unroll
            for (int vt = 0; vt < 4; ++vt) Y[vt] = mfma16(ZV[vt], oAR, mfma16(SO[1][vt], RO[1], mfma16(SO[0][vt], RO[0], Z4)));
            float sum = 0.f;
#pragma unroll
            for (int vt = 0; vt < 4; ++vt) sum += (Y[vt][0] + Y[vt][1]) + (Y[vt][2] + Y[vt][3]);
            sum += SHFL_XOR(sum, 16); sum += SHFL_XOR(sum, 32);
            const float mean = sum * (1.0f / 64.0f);
            float var = 0.f;
#pragma unroll
            for (int vt = 0; vt < 4; ++vt)
#pragma unroll
                for (int r = 0; r < 4; ++r) { const float d = Y[vt][r] - mean; var += d * d; }
            var += SHFL_XOR(var, 16); var += SHFL_XOR(var, 32);
            const float rs = rsqrtf(var * (1.0f / 64.0f) + 64e-5f);
            half_t* yo = p.y0 + (row0 + sc * 16 + lr) * D + 512 + hh * 64 + 4 * lg;
#pragma unroll
            for (int vt = 0; vt < 4; ++vt) {
                const h4 g1 = *(const h4*)(MG + lr * RWS + 16 * vt + 4 * lg), g2 = *(const h4*)(MG2 + lr * RWS + 16 * vt + 4 * lg);
                h4 o;
#pragma unroll
                for (int r = 0; r < 4; ++r) o[r] = (half_t)((Y[vt][r] - mean) * rs * (float)g1[r] + (float)g2[r]);
                *(h4*)(yo + 16 * vt) = o;
            }
        }
#pragma unroll
        for (int kt = 0; kt < 4; ++kt) {
            h4 kx = ZH;
            if (MODE != 1) kx = lds_tr_read(MK + troff + 16 * kt);
            h4 bx = lds_tr_read(MB + troff + 16 * kt);
            bx = bx * (h4){(half_t)rnq[0], (half_t)rnq[1], (half_t)rnq[2], (half_t)rnq[3]};
            const h8 bk = cat8(bx, kx);
#pragma unroll
            for (int vt = 0; vt < 4; ++vt) St[kt][vt] = mfma16(bk, ZV[vt], St[kt][vt]);
        }
        RW_FENCE();
        if (MODE == 1) hs_post(hs + 1, seq + 1);
        if (MODE != 2) ++seq;
    }
    if (MODE != 2) {
        if (MODE == 0) { hs_wait(hs + 1, seq); fvec[lane] = fast_exp2(carry); RW_FENCE(); hs_post(hs, seq + 1); }
        else hs_wait(hs, seq + 1);
        float* dst = cs + (MODE == 0 ? 4096 : 0);
        half_t* Hb = (half_t*)vown;
        f4 fvk[4];
#pragma unroll
        for (int kt = 0; kt < 4; ++kt) fvk[kt] = *(const f4*)(fvec + 16 * kt + 4 * lg);
        RW_FENCE();
        if (MODE == 1) hs_post(hs + 1, seq + 1);
        ++seq;
#pragma unroll
        for (int kt = 0; kt < 4; ++kt) {
            const f4 fv = fvk[kt];
#pragma unroll
            for (int vt = 0; vt < 4; ++vt) {
                const f4 sv = St[kt][vt] * fv;
                if (MODE == 0) *(f4*)(dst + ((kt * 4 + vt) * 64 + lane) * 4) = sv;
                else *(h4*)(Hb + (16 * vt + lr) * RWS + 16 * kt + 4 * lg) = cvt4(sv);
            }
        }
        RW_FENCE();
        if (MODE == 1) {
            half_t* mh = p.rwMh + (size_t)(u * RNC + c) * 4096;
#pragma unroll
            for (int ct = 0; ct < 4; ++ct)
#pragma unroll
                for (int kk = 0; kk < 2; ++kk) {
                    const h4 x0 = lds_tr_read(Hb + (16 * (2 * kk) + 4 * lg + (lr >> 2)) * RWS + 16 * ct + 4 * (lr & 3));
                    const h4 x1 = lds_tr_read(Hb + (16 * (2 * kk + 1) + 4 * lg + (lr >> 2)) * RWS + 16 * ct + 4 * (lr & 3));
                    *(h8*)(mh + ((ct * 2 + kk) * 64 + lane) * 8) = cat8(x0, x1);
                }
            RW_FENCE();
        }
    }
}
__device__ void ph_rwkv_pass1(int vb, int nvb, char* smem_, const P& p) {
    const int w = TIDX >> 6;
    float* vown = (float*)smem_ + w * (RSC * 448 + 16);
    float* vl = (float*)smem_ + (w & 3) * (RSC * 448 + 16);
    unsigned* hsw = (unsigned*)((float*)smem_ + NW * (RSC * 448 + 16));
    __syncthreads();
    if (TIDX < 8) hsw[TIDX] = 0u;
    __syncthreads();
    hs_ptr hs = (hs_ptr)(hsw + 2 * (w & 3));
    unsigned seq = 0;
    for (int item = vb * 4 + (w & 3); item < NB * 8 * RNC; item += nvb * 4) {
        const int u = item / RNC, c = item % RNC;
        if (w >> 2) rwkv_chunk_wave<1>(p, u, c, vl, vown, hs, seq); else rwkv_chunk_wave<0>(p, u, c, vl, vown, hs, seq);
    }
}
struct P2Regs { h8 a[4][2]; f4 L[4]; };
template <bool WIDE>
__device__ void rwkv_pass2_block(const P& p, int u2) {
    const int lane = TIDX & 63, w8 = TIDX >> 6, wv = w8 & 3, u = WIDE ? u2 : 2 * u2 + (w8 >> 2), lr = lane & 15, g = lane >> 4, v = 16 * wv + lr;
    if (WIDE && w8 >= 4) return;
    f4 Dd[4];
#pragma unroll
    for (int i = 0; i < 4; ++i) Dd[i] = (f4){0.f, 0.f, 0.f, 0.f};
    auto load = [&](P2Regs& R, int c) {
        const int cc = c < RNC - 1 ? c : RNC - 2;
        const half_t* mh = p.rwMh + (size_t)(u * RNC + cc) * 4096;
        const float* lc = p.rwCS + (size_t)(u * RNC + cc) * 8192 + 4096;
#pragma unroll
        for (int nt = 0; nt < 4; ++nt) {
#pragma unroll
            for (int kk = 0; kk < 2; ++kk) R.a[nt][kk] = *(const h8*)(mh + ((nt * 2 + kk) * 64 + lane) * 8);
            R.L[nt] = *(const f4*)(lc + ((nt * 4 + wv) * 64 + lane) * 4);
        }
    };
    auto body = [&](P2Regs& R, int c) {
        const h8 s0 = cat8(cvt4(Dd[0]), cvt4(Dd[1])), s1 = cat8(cvt4(Dd[2]), cvt4(Dd[3]));
        float* lc = p.rwCS + (size_t)(u * RNC + c) * 8192 + 4096;
#pragma unroll
        for (int nt = 0; nt < 4; ++nt) { f4 acc = mfma16(R.a[nt][1], s1, mfma16(R.a[nt][0], s0, R.L[nt])); Dd[nt] = acc; *(f4*)(lc + ((nt * 4 + wv) * 64 + lane) * 4) = acc; }
    };
    P2Regs R0, R1, R2;
    load(R0, 0); load(R1, 1); load(R2, 2);
#pragma unroll
    for (int c = 0; c < RNC - 1; c += 3) {
        body(R0, c); load(R0, c + 3);
        if (c + 1 < RNC - 1) { body(R1, c + 1); load(R1, c + 4); }
        if (c + 2 < RNC - 1) { body(R2, c + 2); load(R2, c + 5); }
    }
}
__device__ void ph_rwkv_pass3(int vb, int nvb, char* smem_, const P& p) {
    const int w = TIDX >> 6;
    constexpr int P3R = 4704;
    float* vecs = (float*)smem_ + w * P3R;
    if (w < 4) { for (int gw = vb * 4 + w; gw < NB * 8 * RNC; gw += nvb * 4) { unsigned sq = 0; rwkv_chunk_wave<2>(p, gw / RNC, gw % RNC, vecs, vecs, (hs_ptr)nullptr, sq); } }
    else {
        float* tl = (float*)smem_ + 4 * P3R + (w - 4) * (64 * 65);
        const int wv = vb * 4 + (w - 4), nwv = nvb * 4;
        wave_transpose_w(wv, nwv, tl, p.ff_w1, D, DFF, p.wt_f1, p.norm_gains + 4 * D);
        wave_transpose_w(wv, nwv, tl, p.ff_w2, DFF, D, p.wt_f2, nullptr);
    }
}
__device__ void ph_rwkv_post(int vb, int nvb, const P& p) {
    const int lane = TIDX & 63, w = TIDX >> 6;
    for (long u = (long)vb * NW + w; u < (long)M * 8; u += (long)nvb * NW) {
        const long row = u >> 3; const int hh = (int)(u & 7), c = hh * 64 + lane, tt = (int)(row % T);
        const float y = (float)p.rwY16[row * 512 + c];
        const float mean = wave_sum(y) * (1.0f / 64.0f);
        const float dlt = y - mean;
        const float var = wave_sum(dlt * dlt) * (1.0f / 64.0f);
        const float yn = dlt * rsqrtf(var + 64e-5f) * p.b_ln_w[c] + p.b_ln_b[c];
        const float r = tshift(p.p, row, tt, c, p.b_mu[c]), k0 = tshift(p.p, row, tt, 512 + c, p.b_mu[512 + c]), v = tshift(p.p, row, tt, 1024 + c, p.b_mu[1024 + c]);
        const float a = (float)p.rwA[row * 512 + c];
        const float k = k0 * (1.0f + (a - 1.0f) * p.b_k_a[c]);
        const float bonus = wave_sum(r * k * p.b_r_k[c]) * v;
        p.y0[row * D + 512 + c] = (half_t)((yn + bonus) * (float)p.rwG[row * 512 + c]);
    }
}

__device__ void ph_moba_kmean(int vb, int nvb, char* smem_, const P& p) {
    float* red = (float*)smem_;
    const int tid = TIDX, c = tid & 31, rg = tid >> 5;
    for (int u4 = vb; u4 < NB * NBLK * 4; u4 += nvb) {
        const int u = u4 >> 2, cg = u4 & 3, blk = u % NBLK, b = u / NBLK;
        float s = 0.f;
        const half_t* base = p.p + ((long)b * T + blk * 256 + rg * 16) * ODD_PAD + O_KC + cg * 32 + c;
#pragma unroll 8
        for (int r = 0; r < 16; ++r) s += (float)base[(long)r * ODD_PAD];
        __syncthreads();
        red[tid] = s;
        __syncthreads();
        if (tid < 32) {
            float t = 0.f;
#pragma unroll
            for (int g = 0; g < 16; ++g) t += red[g * 32 + c];
            p.kmean[(long)u * 128 + cg * 32 + c] = t * (1.0f / 256.0f);
        }
    }
}
__device__ void ph_moba_gate(int vb, int nvb, char* smem_, const P& p) {
    float* km = (float*)smem_;
    const int tid = TIDX;
    for (int u = vb; u < M / 256; u += nvb) {
        const long row = (long)u * 256 + (tid >> 1); const int kvh = tid & 1, b = (int)(row / T), t = (int)(row % T), own = t >> 8;
        const int ownmax = (int)(((long)u * 256 + 255) % T) >> 8;
        __syncthreads();
        for (int i = tid; i < ownmax * 128; i += NT) km[i] = p.kmean[(long)b * NBLK * 128 + i];
        __syncthreads();
        float best[3] = {-INFINITY, -INFINITY, -INFINITY}; int bi[3] = {-1, -1, -1};
        if (own > 0) {
            float qs[64];
#pragma unroll
            for (int d = 0; d < 64; ++d) qs[d] = 0.f;
#pragma unroll
            for (int g = 0; g < 4; ++g)
#pragma unroll
                for (int d8 = 0; d8 < 8; ++d8) { h8 v = *(const h8*)(p.p + row * ODD_PAD + O_QC + (kvh * 4 + g) * 64 + d8 * 8);
#pragma unroll
                    for (int j = 0; j < 8; ++j) qs[d8 * 8 + j] += (float)v[j]; }
            for (int n = 0; n < own; ++n) {
                const float* kr = km + n * 128 + kvh * 64;
                float g0 = 0.f, g1 = 0.f, g2 = 0.f, g3 = 0.f;
#pragma unroll
                for (int d = 0; d < 64; d += 4) { f4 kv4 = *(const f4*)(kr + d); g0 += qs[d] * kv4[0]; g1 += qs[d + 1] * kv4[1]; g2 += qs[d + 2] * kv4[2]; g3 += qs[d + 3] * kv4[3]; }
                const float gsum = (g0 + g1) + (g2 + g3);
                if (gsum > best[0]) { best[2] = best[1]; bi[2] = bi[1]; best[1] = best[0]; bi[1] = bi[0]; best[0] = gsum; bi[0] = n; }
                else if (gsum > best[1]) { best[2] = best[1]; bi[2] = bi[1]; best[1] = gsum; bi[1] = n; }
                else if (gsum > best[2]) { best[2] = gsum; bi[2] = n; }
            }
        }
        unsigned mk = 0;
#pragma unroll
        for (int q = 0; q < 3; ++q) if (bi[q] >= 0) mk |= 1u << bi[q];
        p.mmask[row * 2 + kvh] = (unsigned short)mk;
    }
}
__device__ void ph_moba(int vb, int nvb, char* smem, const P& p) {
    const int tid = TIDX, w = tid >> 6, lane = tid & 63, lr = lane & 15, lg = lane >> 4, hd = lr & 3, qi = lr >> 2;
    const half_t* pp = p.p; const int ld = ODD_PAD;
    constexpr int MOBA_BUF = 2 * ATile<64, 128>::BUF;
    constexpr int RTN = 1024 + 81;
    float* rtb = (float*)(smem + MOBA_BUF);
    const float* rt = rtb + hd * RTN;
    unsigned* umx = (unsigned*)(smem + MOBA_BUF + 4 * RTN * 4);
    const int nunits = NB * 2 * (T / 32);
    int lastkv = -1;
    for (int i = 0;; ++i) {
        const int u = snake_unit(i, vb, nvb);
        if (u >= nunits) break;
        const int kvh = u & 1, b = (u >> 1) % NB, t0g = (T / 32 - 1 - (u >> 1) / NB) * 32, t0 = t0g + w * 4, hh = kvh * 4 + hd, tq = t0 + qi, own = t0g >> 8;
        h8 qf[2];
#pragma unroll
        for (int c = 0; c < 2; ++c) qf[c] = *(const h8*)(pp + ((long)b * T + tq) * ld + O_QC + hh * 64 + c * 32 + lg * 8);
        const unsigned mymask = p.mmask[((long)b * T + tq) * 2 + kvh];
        unsigned um = mymask;
        um |= SHFL_XOR(um, 4); um |= SHFL_XOR(um, 8);
        um = SHFL_IDX(um, 0);
        const unsigned umw = um;
        __syncthreads();
        if (kvh != lastkv) { for (int j = tid; j < 4 * RTN; j += NT) { const int h = j / RTN, jj = j % RTN; rtb[j] = (jj < 1024) ? p.bias_dist[(kvh * 4 + h) * 4096 + 1023 - jj] * LOG2E : 0.f; } lastkv = kvh; }
        if (lane == 0) umx[w] = um;
        __syncthreads();
        um = (umx[0] | umx[1]) | (umx[2] | umx[3]) | (umx[4] | umx[5]) | (umx[6] | umx[7]);
        float m = -INFINITY, l = 0.f; f4 o[4];
#pragma unroll
        for (int q = 0; q < 4; ++q) o[q] = (f4){0.f, 0.f, 0.f, 0.f};
        const int nt_own = (t0g + 31 - own * 256) / 128 + 1;
        int blk = 0, st = 0;
        attn_block<64, true, 128>(smem, qf, m, l, o,
            [&](int& s0) {
                for (;;) {
                    if (blk > own) return false;
                    const bool live = (blk == own) || ((um >> blk) & 1);
                    if (live && st < ((blk == own) ? nt_own : 2)) break;
                    ++blk; st = 0;
                }
                s0 = blk * 256 + st * 128; ++st; return true;
            },
            [&](int s0, int row, int ch) { return pp + ((long)b * T + s0 + row) * ld + O_KC + kvh * 64 + ch * 8; },
            [&](int s0, int row, int ch) { return pp + ((long)b * T + s0 + row) * ld + E_VA + kvh * 64 + ch * 8; },
            [&](int s0, f4 (&a)[4]) {
                const int kb = s0 >> 8; const bool sel = (kb == own) || ((mymask >> kb) & 1);
                if (t0g - (s0 + 63) >= 790) {
                    const float bc = rt[0];
#pragma unroll
                    for (int kt = 0; kt < 4; ++kt) a[kt] = a[kt] * (0.125f * LOG2E) + bc;
                } else {
                    const int dq = tq - s0 - 4 * lg;
                    const float* rb = rt + (1023 - dq);
                    if (s0 + 63 <= t0) {
#pragma unroll
                        for (int kt = 0; kt < 4; ++kt)
#pragma unroll
                            for (int q = 0; q < 4; ++q) a[kt][q] = a[kt][q] * (0.125f * LOG2E) + rb[kt * 16 + q];
                    } else {
#pragma unroll
                        for (int kt = 0; kt < 4; ++kt)
#pragma unroll
                            for (int q = 0; q < 4; ++q) a[kt][q] = (kt * 16 + q <= dq) ? a[kt][q] * (0.125f * LOG2E) + rb[kt * 16 + q] : -INFINITY;
                    }
                }
                return sel;
            },
            [&](int s0) { const int kb = s0 >> 8; return (kb == own) ? (s0 > t0 + 3) : !((umw >> kb) & 1); });
        l = rows4_sum(l);
        const float inv = 1.0f / l;
#pragma unroll
        for (int dt = 0; dt < 4; ++dt) {
            h4 ov;
#pragma unroll
            for (int r = 0; r < 4; ++r) ov[r] = (half_t)(o[dt][r] * inv);
            *(h4*)(p.y1 + ((long)b * T + tq) * D + hh * 64 + dt * 16 + 4 * lg) = ov;
        }
    }
}

__device__ void ph_dsa_kin(int vb, int nvb, const P& p) {
    const int lane = TIDX & 63, w = TIDX >> 6;
    const long stride = (long)nvb * NW;
    const float gn = p.d_kidx_norm[lane];
    for (long row0 = (long)vb * NW + w; row0 < M; row0 += 4 * stride) {
        float v[4]; h8 kv[4];
#pragma unroll
        for (int k = 0; k < 4; ++k) {
            const long row = row0 + k * stride < M ? row0 + k * stride : row0;
            v[k] = (float)p.p[row * ODD_PAD + O_KI + lane];
            kv[k] = *(const h8*)(p.p + row * ODD_PAD + O_KD + (lane & 15) * 8);
        }
#pragma unroll
        for (int k = 0; k < 4; ++k) {
            const long row = row0 + k * stride;
            const float ss = wave_sum(v[k] * v[k]);
            if (row < M) {
                p.kin[row * 64 + lane] = (half_t)(v[k] * rsqrtf(ss * (1.0f / 64.0f) + EPS) * gn);
                if (lane < 16) *(h8*)(p.kvd + row * 128 + lane * 8) = kv[k];
            }
        }
    }
}
__device__ __forceinline__ u4 zero_u4() {
    unsigned z = 0u;
#ifndef CPU_EMU
    asm volatile("" : "+v"(z));
#endif
    return (u4){z, z, z, z};
}
__device__ __forceinline__ int mbcnt64(unsigned long long m) {
#ifdef CPU_EMU
    const int lane = (int)(threadIdx.x & 63); return __builtin_popcountll(lane ? (m & (~0ull >> (64 - lane))) : 0ull);
#else
    return (int)__builtin_amdgcn_mbcnt_hi((unsigned)(m >> 32), __builtin_amdgcn_mbcnt_lo((unsigned)m, 0u));
#endif
}
__device__ __forceinline__ unsigned fkey(float f) { unsigned u = __builtin_bit_cast(unsigned, f); return (u & 0x80000000u) ? ~u : (u | 0x80000000u); }
__device__ __forceinline__ void dsa_select_wave(const float* sr, int t, unsigned short* out, unsigned* hist, unsigned* dump  ) {
    const int lane = TIDX & 63;
    constexpr int NJ = T / 64;
    const int n = t + 1;
    if (n <= DSA_K) { for (int i = lane; i < n; i += 64) out[i] = (unsigned short)i; return; }
    unsigned u[NJ];
#ifdef CPU_EMU
    const int nj = (n + 63) >> 6;
#else
    const int nj = __builtin_amdgcn_readfirstlane((n + 63) >> 6);
#endif
    static_assert(NJ % 4 == 0 || NJ < 4, "row quarters");
    constexpr int QJ = NJ >= 4 ? NJ / 4 : NJ;
    auto rows = [&](auto&& f) __attribute__((always_inline)) {
#pragma unroll
        for (int j = 0; j < QJ; ++j) f(j);
        if (NJ > QJ && nj > QJ) {
#pragma unroll
            for (int j = QJ; j < 2 * QJ; ++j) f(j);
            if (nj > 2 * QJ) {
#pragma unroll
                for (int j = 2 * QJ; j < 3 * QJ; ++j) f(j);
                if (nj > 3 * QJ) {
#pragma unroll
                    for (int j = 3 * QJ; j < NJ; ++j) f(j);
                }
            }
        }
    };
    rows([&](int j) __attribute__((always_inline)) { u[j] = __builtin_bit_cast(unsigned, sr[(j < nj ? j : 0) * 64 + lane]); });
    rows([&](int j) __attribute__((always_inline)) { unsigned v = u[j]; PIN(v); u[j] = (j * 64 + lane < n) ? fkey(__builtin_bit_cast(float, v)) : 0u; });
    unsigned prefix = 0u, pmask = 0u; int kk = DSA_K; bool exact = false;
    for (int level = 0; level < 3; ++level) {
        const int shift = level == 0 ? 21 : (level == 1 ? 10 : 0);
        const unsigned bmask = level == 2 ? 1023u : 2047u;
        if (level > 0) {
            WAVE_SYNC();
#pragma unroll
            for (int q = 0; q < 8; ++q) *(u4*)(hist + lane * 32 + q * 4) = zero_u4();
            WAVE_SYNC();
            rows([&](int j) __attribute__((always_inline)) {
                const bool hit = u[j] != 0u && (u[j] & pmask) == prefix;
                unsigned* dst = hit ? hist + ((u[j] >> shift) & bmask) : dump + lane;
#ifdef CPU_EMU
                *dst += 1u;
#else
                (void)__hip_atomic_fetch_add((__attribute__((address_space(3))) unsigned*)dst, 1u, __ATOMIC_RELAXED, __HIP_MEMORY_SCOPE_WORKGROUP);
#endif
            });
        }
        WAVE_SYNC();
        const int b0 = 2048 - 32 * (lane + 1);
        unsigned hb[32]; unsigned sl = 0;
#pragma unroll
        for (int q = 0; q < 8; ++q) { const u4 v = *(const u4*)(hist + b0 + q * 4);
#pragma unroll
            for (int e = 0; e < 4; ++e) { hb[q * 4 + e] = v[e]; sl += v[e]; } }
        const unsigned pre = wave_prefix_sum(sl);
        const unsigned long long bm = __ballot((int)pre >= kk);
        const int L = bm ? __builtin_ctzll(bm) : 63;
        int tb = -1; unsigned ca = 0, bc = 0, run = pre - sl;
#pragma unroll
        for (int q = 31; q >= 0; --q) { const bool hit = (tb < 0) && ((int)(run + hb[q]) >= kk); if (hit) { tb = q; ca = run; bc = hb[q]; } run += hb[q]; }
        const int tbin = (int)bcast_u((unsigned)(tb + b0), L); const unsigned cab = bcast_u(ca, L), bcn = bcast_u(bc, L);
        kk -= (int)cab; prefix |= (unsigned)tbin << shift; pmask |= bmask << shift;
        if ((int)bcn == kk) { exact = true; break; }
    }
    const unsigned thr = prefix;
    const int need = kk;
    unsigned short* ol = (unsigned short*)(hist + 2048 - 160);
    WAVE_SYNC();
    if (exact) {
        int mine = 0;
        rows([&](int j) __attribute__((always_inline)) { mine += (u[j] >= thr) ? 1 : 0; });
        int pos = (int)wave_prefix_sum((unsigned)mine) - mine;
        rows([&](int j) __attribute__((always_inline)) {
            const bool sel = u[j] >= thr;
            ol[sel ? pos : 256 + lane] = (unsigned short)(j * 64 + lane);
            pos += sel ? 1 : 0;
        });
    } else {
        int eqbase = 0, pos = 0;
        rows([&](int j) __attribute__((always_inline)) {
            const bool eq = (u[j] == thr);
            const unsigned long long beq = __ballot(eq);
            const int erank = eqbase + mbcnt64(beq);
            const bool sel = (u[j] > thr) || (eq && erank < need);
            const unsigned long long bs = __ballot(sel);
            if (sel) ol[pos + mbcnt64(bs)] = (unsigned short)(j * 64 + lane);
            eqbase += __popcll(beq); pos += __popcll(bs);
        });
    }
    WAVE_SYNC();
    { typedef unsigned long long __attribute__((may_alias)) u64a;
#ifndef CPU_EMU
      asm volatile("s_waitcnt lgkmcnt(0)" ::: "memory");
#endif
      *(u64a*)(out + lane * 4) = *(const u64a*)(ol + lane * 4); }
}
__device__ __forceinline__ void ph_dsa_index(int vb, int nvb, char* smem_, const P& p) {
    const int lane = TIDX & 63, w = TIDX >> 6, lr = lane & 15, lg = lane >> 4;
    const int nt = T / 16, nunits = NB * nt;
    float* scr = p.scores + (long)vb * 16 * SCS;
    for (int i = 0;; ++i) {
        const int un = snake_unit(i, vb, nvb);
        if (un >= nunits) break;
        const int b = un % NB, t0 = (nt - 1 - un / NB) * 16, tq = t0 + lr;
        const long row = (long)b * T + tq;
        h8 qf[4][2]; float wv[4];
#pragma unroll
        for (int ih = 0; ih < 4; ++ih) {
            wv[ih] = (float)p.p[row * ODD_PAD + O_WI + ih] * 0.0625f;
#pragma unroll
            for (int c = 0; c < 2; ++c) qf[ih][c] = *(const h8*)(p.p + row * ODD_PAD + O_QI + ih * 64 + c * 32 + lg * 8);
        }
        __syncthreads();
        unsigned* hq = (unsigned*)smem_;
        { const u4 zz = zero_u4(); for (int i = TIDX; i < 16 * 2048 / 4; i += NT) ((u4*)hq)[i] = zz; }
        __syncthreads();
        const int nkt = t0 / 16 + 1;
        auto ldk = [&](h8 (&kf)[2], int kt) {
            const int kc = kt < nkt ? kt : nkt - 1;
#pragma unroll
            for (int c = 0; c < 2; ++c) kf[c] = *(const h8*)(p.kin + ((long)b * T + kc * 16 + lr) * 64 + c * 32 + lg * 8);
        };
        auto score = [&](const h8 (&kf)[2], int kt) {
            f4 sc = (f4){0.f, 0.f, 0.f, 0.f};
#pragma unroll
            for (int ih = 0; ih < 4; ++ih) {
                f4 acc = (f4){0.f, 0.f, 0.f, 0.f};
                acc = mfma16(kf[0], qf[ih][0], acc); acc = mfma16(kf[1], qf[ih][1], acc);
#pragma unroll
                for (int r = 0; r < 4; ++r) sc[r] += wv[ih] * fmaxf(acc[r], 0.f);
            }
            *(f4*)(scr + (long)lr * SCS + kt * 16 + 4 * lg) = sc;
#pragma unroll
            for (int r = 0; r < 4; ++r) {
                unsigned* dst = (kt * 16 + 4 * lg + r <= tq) ? hq + lr * 2048 + (fkey(sc[r]) >> 21) : (unsigned*)(smem_ + 131072) + w * 64 + lane;
#ifdef CPU_EMU
                *dst += 1u;
#else
                (void)__hip_atomic_fetch_add((__attribute__((address_space(3))) unsigned*)dst, 1u, __ATOMIC_RELAXED, __HIP_MEMORY_SCOPE_WORKGROUP);
#endif
            }
        };
        h8 kA[2], kB[2];
        ldk(kA, w);
        for (int kt = w; kt < nkt; kt += 2 * NW) {
            ldk(kB, kt + NW);
            SCHED_FENCE();
            score(kA, kt);
            if (kt + NW >= nkt) break;
            ldk(kA, kt + 2 * NW);
            SCHED_FENCE();
            score(kB, kt + NW);
        }
        __syncthreads();
        for (int qi = w; qi < 16; qi += NW) dsa_select_wave(scr + (long)qi * SCS, t0 + qi, p.dsel + ((long)b * T + t0 + qi) * 256, hq + qi * 2048, (unsigned*)(smem_ + 131072) + w * 64);
    }
}
struct DsaRegs { h8 kr[4]; h8 vr[4]; int s0; };
constexpr int DVS = 72;
__device__ void ph_dsa(int vb, int nvb, char* smem_, const P& p) {
    const int tid = TIDX, w = tid >> 6, lane = tid & 63, lr = lane & 15, lg = lane >> 4, hh = lr & 7;
    constexpr int BTS = 1025;
    float* btab = (float*)smem_;
    unsigned short* sidx = (unsigned short*)(smem_ + 33024) + w * 512;
    unsigned short* sdist = (unsigned short*)(smem_ + 33024 + 8192) + w * 512;
    half_t* vbuf = (half_t*)(smem_ + 33024 + 16384) + w * (32 * DVS);
    half_t* kbuf = (half_t*)(smem_ + 33024 + 16384 + NW * 32 * DVS * 2) + w * (32 * DVS);
    __syncthreads();
    for (int i = tid; i < 8 * 1024; i += NT) btab[(i >> 10) * BTS + (i & 1023)] = p.bias_dist[(i >> 10) * 4096 + (i & 1023)] * LOG2E;
    __syncthreads();
    const half_t* pp = p.p; const int ld = ODD_PAD;
    const float* bd = btab + hh * BTS;
    long stride = (long)nvb * NW, row = (long)vb * NW + w, rend = M;
    if ((nvb & 7) == 0 && (8 % NB) == 0) {
        const int xpb = 8 / NB, x = vb & 7, part = x % xpb, wid = (vb >> 3) * NW + w, wpx = (nvb >> 3) * NW;
        row = (long)(x / xpb) * T + (long)wid * xpb + part; stride = (long)wpx * xpb; rend = (long)(x / xpb + 1) * T;
    }
    if (row >= rend) return;
    typedef unsigned long long __attribute__((may_alias)) u64a;
    auto fetch_sel = [&](long r) { return *(const u64a*)(p.dsel + r * 256 + lane * 4); };
    auto put_sel = [&](u64a v, int t, int buf) {
        u64a dv = 0;
#pragma unroll
        for (int e = 0; e < 4; ++e) { int d = t - (int)((v >> (16 * e)) & 0xffffu); d = d < 0 ? 0 : (d > 1023 ? 1023 : d); dv |= (u64a)(unsigned)d << (16 * e); }
        WAVE_SYNC();
        *(u64a*)(sidx + buf * 256 + lane * 4) = v; *(u64a*)(sdist + buf * 256 + lane * 4) = dv;
#ifndef CPU_EMU
        asm volatile("s_waitcnt lgkmcnt(0)" ::: "memory");
#endif
        WAVE_SYNC();
    };
    auto load_q = [&](h8 (&qf)[2], long r) {
#pragma unroll
        for (int c = 0; c < 2; ++c) qf[c] = *(const h8*)(pp + r * ld + O_QD + hh * 64 + c * 32 + lg * 8);
    };
    auto load = [&](DsaRegs& r, long rb, int cnt, int buf, int s0) {
        r.s0 = s0;
        const unsigned short* si = sidx + buf * 256;
        const int slv = s0 + (lane >> 3);
        int kv0 = si[slv < cnt ? slv : cnt - 1], kv1 = si[slv + 8 < cnt ? slv + 8 : cnt - 1], kv2 = si[slv + 16 < cnt ? slv + 16 : cnt - 1], kv3 = si[slv + 24 < cnt ? slv + 24 : cnt - 1];
#ifndef CPU_EMU
        asm volatile("" : "+v"(kv0), "+v"(kv1), "+v"(kv2), "+v"(kv3));
#endif
        { const int kc = (lane & 7) * 8;
          const half_t* a0 = p.kvd + (rb + kv0) * 128 + kc; const half_t* a1 = p.kvd + (rb + kv1) * 128 + kc; const half_t* a2 = p.kvd + (rb + kv2) * 128 + kc; const half_t* a3 = p.kvd + (rb + kv3) * 128 + kc;
          r.kr[0] = *(const h8*)a0; r.kr[1] = *(const h8*)a1; r.kr[2] = *(const h8*)a2; r.kr[3] = *(const h8*)a3;
          r.vr[0] = *(const h8*)(a0 + 64); r.vr[1] = *(const h8*)(a1 + 64); r.vr[2] = *(const h8*)(a2 + 64); r.vr[3] = *(const h8*)(a3 + 64); }
    };
    float m = -INFINITY, l = 0.f; f4 o[4];
    auto compute = [&](DsaRegs& r, const h8 (&qf)[2], int cnt, int buf) {
        WAVE_SYNC();
#ifdef CPU_EMU
#pragma unroll
        for (int q = 0; q < 4; ++q) { *(h8*)(vbuf + (q * 8 + (lane >> 3)) * DVS + (lane & 7) * 8) = r.vr[q]; *(h8*)(kbuf + (q * 8 + (lane >> 3)) * DVS + (lane & 7) * 8) = r.kr[q]; }
#else
#pragma unroll
        for (int q = 0; q < 4; ++q) {
            *(__attribute__((address_space(3))) h8*)(vbuf + (q * 8 + (lane >> 3)) * DVS + (lane & 7) * 8) = r.vr[q];
            *(__attribute__((address_space(3))) h8*)(kbuf + (q * 8 + (lane >> 3)) * DVS + (lane & 7) * 8) = r.kr[q];
        }
        asm volatile("s_waitcnt lgkmcnt(0)" ::: "memory");
#endif
        WAVE_SYNC();
        const unsigned short* sd = sdist + buf * 256;
        float bv[2][4];
        {
            typedef unsigned long long __attribute__((may_alias)) u64b;
            u64b d0 = *(const u64b*)(sd + r.s0 + 4 * lg), d1 = *(const u64b*)(sd + r.s0 + 16 + 4 * lg);
#ifndef CPU_EMU
            asm volatile("" : "+v"(d0), "+v"(d1));
#endif
#pragma unroll
            for (int q = 0; q < 4; ++q) { bv[0][q] = bd[(int)((d0 >> (16 * q)) & 0xffffu)]; bv[1][q] = bd[(int)((d1 >> (16 * q)) & 0xffffu)]; }
#ifndef CPU_EMU
            asm volatile("" : "+v"(bv[0][0]), "+v"(bv[0][1]), "+v"(bv[0][2]), "+v"(bv[0][3]), "+v"(bv[1][0]), "+v"(bv[1][1]), "+v"(bv[1][2]), "+v"(bv[1][3]));
#endif
        }
        f4 sv[2];
#pragma unroll
        for (int tl = 0; tl < 2; ++tl) {
            f4 acc = (f4){0.f, 0.f, 0.f, 0.f};
#pragma unroll
            for (int c = 0; c < 2; ++c) acc = mfma16(*(const h8*)(kbuf + (tl * 16 + lr) * DVS + c * 32 + lg * 8), qf[c], acc);
#pragma unroll
            for (int q = 0; q < 4; ++q) {
                const int sl2 = r.s0 + tl * 16 + 4 * lg + q;
                const float sc = acc[q] * (0.125f * LOG2E) + bv[tl][q];
                acc[q] = (sl2 < cnt) ? sc : -INFINITY;
            }
            sv[tl] = acc;
        }
        h8 vf[4];
#pragma unroll
        for (int dt = 0; dt < 4; ++dt) {
            const half_t* a0 = vbuf + (4 * lg + (lr >> 2)) * DVS + dt * 16 + 4 * (lr & 3);
            const h4 x = lds_tr_read(a0), y = lds_tr_read(a0 + 16 * DVS);
            vf[dt] = (h8){x[0], x[1], x[2], x[3], y[0], y[1], y[2], y[3]};
        }
        attn_step<4>(sv[0], sv[1], vf, m, l, o);
    };
    int t = (int)(row % T); long rb = row - t; int cnt = (t + 1 < DSA_K) ? t + 1 : DSA_K; int buf = 0;
    put_sel(fetch_sel(row), t, 0);
    h8 qf[2], nqf[2];
    load_q(qf, row);
    DsaRegs R0, R1, R2, R3;
    load(R0, rb, cnt, 0, 0); load(R1, rb, cnt, 0, 32); load(R2, rb, cnt, 0, 64);
    for (;;) {
        const long nrow = row + stride; const bool hn = nrow < rend;
        const long nr = hn ? nrow : row; const int nt = (int)(nr % T); const long nrb = nr - nt; const int ncnt = (nt + 1 < DSA_K) ? nt + 1 : DSA_K;
        const u64a nsv = fetch_sel(nr);
        m = -INFINITY; l = 0.f;
#pragma unroll
        for (int i = 0; i < 4; ++i) o[i] = (f4){0.f, 0.f, 0.f, 0.f};
        load(R3, rb, cnt, buf, 96); SCHED_FENCE(); compute(R0, qf, cnt, buf);
        load(R0, rb, cnt, buf, 128); SCHED_FENCE(); compute(R1, qf, cnt, buf);
        load(R1, rb, cnt, buf, 160); SCHED_FENCE(); compute(R2, qf, cnt, buf);
        put_sel(nsv, nt, buf ^ 1); load_q(nqf, nr);
        load(R2, rb, cnt, buf, 192); SCHED_FENCE(); compute(R3, qf, cnt, buf);
        load(R3, rb, cnt, buf, 224); SCHED_FENCE(); compute(R0, qf, cnt, buf);
        load(R0, nrb, ncnt, buf ^ 1, 0); SCHED_FENCE(); compute(R1, qf, cnt, buf);
        load(R1, nrb, ncnt, buf ^ 1, 32); SCHED_FENCE(); compute(R2, qf, cnt, buf);
        load(R2, nrb, ncnt, buf ^ 1, 64); SCHED_FENCE(); compute(R3, qf, cnt, buf);
        l = rows4_sum(l);
        const float inv = 1.0f / l;
        if (lr < 8) {
#pragma unroll
            for (int dt = 0; dt < 4; ++dt) {
                h4 ov;
#pragma unroll
                for (int r = 0; r < 4; ++r) ov[r] = (half_t)(o[dt][r] * inv);
                *(h4*)(p.y1 + row * D + 512 + hh * 64 + dt * 16 + 4 * lg) = ov;
            }
        }
        if (!hn) break;
        row = nrow; t = nt; rb = nrb; cnt = ncnt; buf ^= 1; qf[0] = nqf[0]; qf[1] = nqf[1];
    }
}

constexpr int NPH_L = 15;
constexpr int NPHASE = 1 + 2 * NPH_L;
constexpr int SMEM_BYTES = 144 * 1024;
static_assert(SMEM_BYTES >= ATT_BUF64 + 4 * 1024 * 4, "smem");
__device__ void run_phase(const P& p, int ph, char* smem) {
    const int vb = opaque_s(blockIdx.x), nvb = opaque_s(gridDim.x);
    if (ph == 0) {
        ph_bias_table(vb, nvb, p.rel_bias, p.bias_dist);
        ph_transpose_w(vb, nvb, smem, p.ev_w_in, D, EVEN_IN, p.wt_ev, EVEN_IN, p.norm_gains + 0 * D);
        ph_transpose_w(vb, nvb, smem, p.mix_w_out, D, D, p.wt_mix, D);
        for (int kh = 0; kh < 2; ++kh) ph_transpose_w(vb, nvb, smem, p.x_wq + (size_t)kh * 512 * 512, 512, 512, p.wt_q + (size_t)kh * 512 * 512, 512, p.norm_gains + 2 * D + kh * 512);
        ph_transpose_w(vb, nvb, smem, p.x_wkv, D, 1024, p.wt_kv, 1024);
        ph_transpose_w(vb, nvb, smem, p.x_wo, 512, D, p.wt_o, D);
        ph_transpose_w(vb, nvb, smem, p.b_w2, 64, 512, p.wt_w2, 512);
        ph_transpose_w(vb, nvb, smem, p.b_a2, 64, 512, p.wt_a2, 512);
        ph_transpose_w(vb, nvb, smem, p.b_g2, 128, 512, p.wt_g2, 512);
        ph_rmsnorm(vb, nvb, p.x, p.norm_gains, p.h, M, (half_t*)p.out + (size_t)M * D, p.xs2);
        ph_rmsnorm(vb, nvb, p.mem, p.mem_norm, p.memn, NB * MEM);
        return;
    }
    const int l = (ph - 1) / NPH_L, s = (ph - 1) % NPH_L;
    const float* g = p.norm_gains + (size_t)l * 6 * D;
    {
        const half_t *gA = nullptr, *gB = nullptr; int gN = 0, gK = 0, ng = 1;
        GemmEpi ge{}; ge.act = EPI_F16;
        const int fz = l * 3;
        half_t* xa = (half_t*)p.out; half_t* xb2 = (half_t*)p.out + (size_t)M * D; half_t* xc = (half_t*)(p.big + (size_t)M * DFF * 2);
        const int fi = fz + (s < 8 ? 0 : (s < 12 ? 1 : 2));
        const half_t* xres = (fi == 5) ? xc : ((fi & 1) ? xa : xb2);
        switch (s) {
        case 0: gA = xres; gB = (l == 0) ? p.wt_ev : p.wt_od; ge.O = p.p; gN = (l == 0) ? EVEN_IN : ODD_PAD; gK = D; ng = 2; ge.xs2_in = p.xs2; break;
        case 6: gA = (l == 0) ? p.y0 : p.y1; gB = p.wt_mix; gN = D; gK = D; ge.fused = 1; ge.g_post = g + 1 * D; ge.g_pre = g; ge.xs = p.xs + (size_t)(fz + 0) * 65536; ge.cnt = p.bar + 4096 + 64 * (fz + 0); break;
        case 8: gA = xres; gB = p.wt_q; ge.O = p.xq; gN = 1024; gK = 512; ge.xs2_in = p.xs2; break;
        case 10: gA = p.xo; gB = p.wt_o; gN = D; gK = 512; ge.fused = 1; ge.g_post = g + 3 * D; ge.g_pre = g; ge.xs = p.xs + (size_t)(fz + 1) * 65536; ge.cnt = p.bar + 4096 + 64 * (fz + 1); break;
        case 12: gA = xres; gB = p.wt_f1; ge.O = p.u; gN = DFF; gK = D; ge.act = EPI_RELU2; ge.xs2_in = p.xs2; break;
        case 13: gA = p.u; gB = p.wt_f2; gN = D; gK = DFF; ge.fused = 1; ge.g_post = g + 5 * D; ge.g_pre = (l == 0) ? g : (const float*)nullptr; ge.xs = p.xs + (size_t)(fz + 2) * 65536; ge.cnt = p.bar + 4096 + 64 * (fz + 2); break;
        default: ng = 0; break;
        }
        ge.ldc = gN; ge.hx = nullptr; ge.xs2_out = p.xs2;
        ge.x_in = xres; ge.x_out = (fi == 5) ? (void*)p.out : (fi == 4 ? (void*)xc : ((fi & 1) ? (void*)xb2 : (void*)xa)); ge.xin16 = 1; ge.xout16 = (fi != 5);
        for (int gi = 0; gi < ng; ++gi) {
            int gM = M, gvb = vb;
            if (gi == 1) { gA = p.memn; gB = p.wt_kv; ge.O = p.memkv; gN = 1024; gK = D; ge.ldc = 1024; ge.xs2_in = nullptr; gM = NB * MEM; gvb = (vb + 16) % nvb; }
            ph_gemm(ge, gvb, nvb, smem, gA, gB, gM, gN, gK, (s == 8) ? D : gK, (s == 8 && gi == 0) ? 2 : 0);
        }
    }
    switch (s) {
    case 0:
        if (l == 1 && nvb == 256 && vb >= 192 && vb < 240) ph_transpose_w(vb - 192, 48, smem, p.ff_w2 + (size_t)DFF * D, DFF / 2, D, p.wt_f2, D, nullptr, DFF);
        if (l == 1 && nvb != 256) ph_transpose_w(vb, nvb, smem, p.ff_w2 + (size_t)DFF * D, DFF / 2, D, p.wt_f2, D, nullptr, DFF);
        break;
    case 1:
        if (l == 0) ph_rwkv_prep(vb, nvb, smem, p);
        else { ph_moba_kmean(vb, nvb, smem, p); ph_dsa_kin(vb, nvb, p); ph_transpose_w(vb, nvb, smem, p.ff_w2 + (size_t)DFF * D + (size_t)(DFF / 2) * D, DFF / 2, D, p.wt_f2 + DFF / 2, D, nullptr, DFF); }
        break;
    case 2:
        if (l == 0) ph_rwkv_pass1(vb, nvb, smem, p);
        else {
            if (vb < DSA_SCR_BLOCKS) ph_dsa_index(vb, nvb < DSA_SCR_BLOCKS ? nvb : DSA_SCR_BLOCKS, smem, p);
            ph_moba_gate(vb, nvb, smem, p);
        }
        break;
    case 3:
        if (l == 0) {
            if (nvb > NB * 16) { if (vb < NB * 8) rwkv_pass2_block<true>(p, vb); ph_swa(vb, nvb, smem, p, p.bar + 4096 + 64 * 6); }
            else { for (int u = vb; u < NB * 4; u += nvb) rwkv_pass2_block<false>(p, u); ph_swa(vb, nvb, smem, p); }
        } else { ph_moba(vb, nvb, smem, p); ph_dsa(vb, nvb, smem, p); }
        break;
    case 4: if (l == 0) ph_rwkv_pass3(vb, nvb, smem, p); break;
    case 5: break;
    case 6: break;
    case 7: break;
    case 8: break;
    case 9: ph_xattn(vb, nvb, smem, p); break;
    case 10: break;
    case 11: break;
    case 12:
        if (l == 0) {
            ph_transpose_w(vb, nvb, smem, p.od_w_in, D, ODD_IN, p.wt_od, ODD_PAD, p.norm_gains + 6 * D);
            ph_transpose_w(vb, nvb, smem, p.mix_w_out + (size_t)D * D, D, D, p.wt_mix, D);
            for (int kh = 0; kh < 2; ++kh) ph_transpose_w(vb, nvb, smem, p.x_wq + (size_t)D * 512 + (size_t)kh * 512 * 512, 512, 512, p.wt_q + (size_t)kh * 512 * 512, 512, p.norm_gains + 8 * D + kh * 512);
            ph_transpose_w(vb, nvb, smem, p.x_wkv + (size_t)D * 1024, D, 1024, p.wt_kv, 1024);
            ph_transpose_w(vb, nvb, smem, p.x_wo + (size_t)512 * D, 512, D, p.wt_o, D);
            ph_rmsnorm(vb, nvb, p.mem, p.mem_norm + D, p.memn, NB * MEM);
        }
        break;
    case 13:
        if (l == 0) ph_transpose_w(vb, nvb, smem, p.ff_w1 + (size_t)D * DFF, D, DFF, p.wt_f1, DFF, p.norm_gains + 10 * D);
        break;
    case 14: break;
    }
}
__device__ __forceinline__ bool phase_empty(int ph) { const int s_ = (ph - 1) % NPH_L; return ph >= 1 && (s_ == 5 || s_ == 7 || s_ == 11 || s_ == 14 || (ph >= 1 + NPH_L && s_ == 4)); }


#ifndef PROBE_REPS
#define PROBE_REPS(ph) 1
#endif
#ifndef CPU_EMU
#define XB_TMO      128
#define XB_XCNT(j)  (256  + 64 * (j))
#define XB_XSUB(j)  (1280 + 64 * (j))
#define XB_XGEN(j)  (2304 + 64 * (j))
#define XB_TOP      3328
#define XB_TOPGEN   3392
#define XCD_BAR_WORDS 3456
#define XB_SPIN_CAP (1u << 20)
#define LAS __attribute__((address_space(3)))
__device__ __forceinline__ unsigned xb_ld(unsigned* p)              { return __hip_atomic_load(p, __ATOMIC_RELAXED, __HIP_MEMORY_SCOPE_AGENT); }
__device__ __forceinline__ unsigned xb_add(unsigned* p, unsigned v) { return __hip_atomic_fetch_add(p, v, __ATOMIC_RELAXED, __HIP_MEMORY_SCOPE_AGENT); }
__device__ __forceinline__ unsigned xb_xcc_id() { return (unsigned)__builtin_amdgcn_s_getreg((3 << 11) | 20) & 0xFu; }
#define XB_SPIN(cond, bar) do { unsigned _sp = 0; while (cond) { __builtin_amdgcn_s_sleep(1); \
    if ((++_sp & 255u) == 0u) { if (xb_ld(&(bar)[XB_TMO])) break; if (_sp > XB_SPIN_CAP) { atomicAdd(&(bar)[XB_TMO], 1u); break; } } } } while (0)
struct XcdBarrier { unsigned* bar; unsigned x; volatile LAS unsigned* st; };
__device__ __forceinline__ XcdBarrier xcd_barrier_post(unsigned* bar, volatile LAS unsigned* st) {
    XcdBarrier b; b.bar = bar; b.x = xb_xcc_id(); b.st = st;
    if (threadIdx.x == 0) (void)xb_add(&bar[XB_XCNT(b.x)], 1u);
    return b;
}
__device__ __forceinline__ void xcd_barrier_complete(unsigned* bar, unsigned x, unsigned& nloc, unsigned& nx) {
    const unsigned G = gridDim.x * gridDim.y * gridDim.z;
    unsigned sum, cnt, mine, sp = 0u;
    for (;;) {
        sum = 0u; cnt = 0u; mine = 0u;
#pragma unroll
        for (unsigned j = 0; j < 16; ++j) { const unsigned c = xb_ld(&bar[XB_XCNT(j)]); sum += c; cnt += (c > 0u) ? 1u : 0u; mine = (j == x) ? c : mine; }
        if (sum == G) break;
        __builtin_amdgcn_s_sleep(1);
        if ((++sp & 255u) == 0u) { if (xb_ld(&bar[XB_TMO])) break; if (sp > XB_SPIN_CAP) { atomicAdd(&bar[XB_TMO], 1u); break; } }
    }
    nloc = mine > 0u ? mine : 1u; nx = cnt > 0u ? cnt : 1u;
}
__device__ __forceinline__ void xcd_barrier(const XcdBarrier& b) {
    asm volatile("s_waitcnt vmcnt(0)" ::: "memory");
    __syncthreads();
    if (threadIdx.x == 0) {
        unsigned* bar = b.bar;
        __builtin_amdgcn_s_waitcnt(0);
        unsigned nloc = b.st[0], nx = b.st[1];
        if (nloc == 0u) { xcd_barrier_complete(bar, b.x, nloc, nx); b.st[0] = nloc; b.st[1] = nx; }
        const unsigned old = xb_add(&bar[XB_XSUB(b.x)], 1u);
        const unsigned gen = old / nloc;
        if (old + 1u == (gen + 1u) * nloc) {
            __builtin_amdgcn_fence(__ATOMIC_RELEASE, "agent");
            asm volatile("s_waitcnt vmcnt(0)" ::: "memory");
            const unsigned og = xb_add(&bar[XB_TOP], 1u);
            const unsigned tg = og / nx;
            if (og + 1u == (tg + 1u) * nx) xb_add(&bar[XB_TOPGEN], 1u);
            else XB_SPIN(xb_ld(&bar[XB_TOPGEN]) == tg, bar);
            __builtin_amdgcn_fence(__ATOMIC_ACQUIRE, "agent");
            xb_add(&bar[XB_XGEN(b.x)], 1u);
            asm volatile("s_waitcnt vmcnt(0)" ::: "memory");
        } else {
            XB_SPIN(xb_ld(&bar[XB_XGEN(b.x)]) == gen, bar);
            __builtin_amdgcn_fence(__ATOMIC_ACQUIRE, "agent");
            asm volatile("s_waitcnt vmcnt(0)" ::: "memory");
        }
    }
    __syncthreads();
}
#ifndef CPU_EMU
#pragma clang attribute pop
#endif
__global__ void __launch_bounds__(512, 2) mega_kernel(P p) {
    extern __shared__ __attribute__((aligned(16))) char smem[];
    cooperative_groups::grid_group grid = cooperative_groups::this_grid();
    volatile LAS unsigned* st = (volatile LAS unsigned*)(smem + SMEM_BYTES);
    if (threadIdx.x == 0) { st[0] = 0u; st[1] = 0u; st[2] = 0u; st[3] = 0u; }
    __syncthreads();
    (void)xcd_barrier_post(p.bar, st);
    for (int ph = 0; ph < NPHASE; ++ph) {
        if (phase_empty(ph)) continue;
        for (int rep = 0; rep < PROBE_REPS(ph); ++rep) {
            run_phase(p, ph, smem);
            if (ph == 0) grid.sync();
            else if (ph + 1 < NPHASE || rep + 1 < PROBE_REPS(ph)) { XcdBarrier xb; xb.bar = p.bar; xb.x = xb_xcc_id(); xb.st = (volatile LAS unsigned*)(smem + SMEM_BYTES); xcd_barrier(xb); }
        }
    }
}
#else
static void emu_phase_kernel(P p, int ph) {
    static __attribute__((aligned(16))) char smem[SMEM_BYTES + 16];
    run_phase(p, ph, smem);
}
#endif

}

#ifdef CPU_EMU
static P g_dbgP;
static void (*g_dbg_hook)(int, int) = nullptr;
#endif

extern "C" void kernel_launch(void* const* d_in, const int* in_sizes, int n_in, void* d_out, int out_size, void* d_ws, size_t ws_size, hipStream_t stream) {
    (void)in_sizes; (void)n_in; (void)out_size;
    P p{};
    const float** ins = (const float**)&p;
    for (int i = 0; i < 26; ++i) ins[i] = (const float*)d_in[i];
    p.out = (float*)d_out;
    char* ws = (char*)d_ws; size_t off = 0;
    auto alloc = [&](size_t bytes) { void* r = ws + off; off += (bytes + 255) & ~(size_t)255; return r; };
    p.bar = (unsigned*)alloc((4096 + 64 * 7) * 4);
    p.xs = (float*)alloc((size_t)6 * 65536 * 4); p.xs2 = (float*)alloc((size_t)65536 * 4);
    p.wt_ev = (half_t*)alloc((size_t)EVEN_IN * D * 2); p.wt_od = p.wt_ev;
    p.wt_mix = (half_t*)alloc((size_t)D * D * 2); p.wt_q = (half_t*)alloc((size_t)512 * D * 2);
    p.wt_kv = (half_t*)alloc((size_t)1024 * D * 2); p.wt_o = (half_t*)alloc((size_t)D * 512 * 2);
    p.wt_f1 = (half_t*)alloc((size_t)DFF * D * 2); p.wt_f2 = (half_t*)alloc((size_t)D * DFF * 2);
    p.wt_w2 = (half_t*)alloc(512 * 64 * 2); p.wt_a2 = (half_t*)alloc(512 * 64 * 2); p.wt_g2 = (half_t*)alloc(512 * 128 * 2);
    p.memn = (half_t*)alloc((size_t)NB * MEM * D * 2); p.memkv = (half_t*)alloc((size_t)NB * MEM * 1024 * 2); p.memvT = (half_t*)alloc((size_t)NB * 512 * (MEM + 8) * 2);
    p.vT = (half_t*)alloc((size_t)NB * 128 * VTS * 2);
    p.kmean = (float*)alloc((size_t)NB * NBLK * 128 * 4); p.bias_dist = (float*)alloc(8 * 4096 * 4);
    p.mmask = (unsigned short*)alloc((size_t)M * 2 * 2);
    { char* xr = (char*)alloc((size_t)M * 512 * 2); p.rwY16 = (half_t*)xr; p.dsel = (unsigned short*)xr; p.kin = (half_t*)(xr + (size_t)M * 256 * 2); }
    p.h = (half_t*)alloc((size_t)M * D * 2); p.o = p.h; p.rwCS = (float*)p.h; p.kvd = p.h;
    p.rwMh = (half_t*)d_out;
    static_assert((size_t)NB * 8 * RNC * 8192 * 4 <= (size_t)M * D * 2, "chunk summaries must fit in R_h");
    static_assert((size_t)M * 256 * 2 + (size_t)M * 64 * 2 <= (size_t)M * 512 * 2, "dsel + kin fit");
    p.big = (char*)alloc(0);
    size_t bigsz = SZ_P0 + SZ_Y + 3 * SZ_C;
    if (SZ_P1 + SZ_Y + SZ_SCR > bigsz) bigsz = SZ_P1 + SZ_Y + SZ_SCR;
    if ((size_t)M * DFF * 2 > bigsz) bigsz = (size_t)M * DFF * 2;
    off += bigsz;
    if (off > ws_size) { fprintf(stderr, "workspace too small: need %zu have %zu\n", off, ws_size); }
    p.u = (half_t*)p.big; p.xq = (half_t*)p.big; p.xo = (half_t*)(p.big + 2 * SZ_C);
    p.p = (half_t*)p.big; p.y0 = (half_t*)(p.big + SZ_P0); p.y1 = (half_t*)(p.big + SZ_P1);
    p.rwL = (half_t*)(p.big + SZ_P0 + SZ_Y); p.rwA = p.rwL + (size_t)M * 512; p.rwG = p.rwA + (size_t)M * 512;
    p.scores = (float*)(p.big + SZ_P1 + SZ_Y);
#ifdef CPU_EMU
    for (int ph = 0; ph < NPHASE; ++ph) {
        emu::launch(dim3(8), dim3(NT), [=] { emu_phase_kernel(p, ph); });
        const int l = (ph - 1) / NPH_L, s = (ph - 1) % NPH_L;
        if (ph >= 1 && g_dbg_hook) {
            g_dbgP = p;
            if (s == 5) g_dbg_hook(l, 0);
            if (s == 7) g_dbg_hook(l, 1);
            if (s == 9) g_dbg_hook(l, 2);
            if (s == 11) g_dbg_hook(l, 3);
            if (s == 14) g_dbg_hook(l, 4);
        }
    }
#else
    static int grid_blocks = 0;
    if (!grid_blocks) {
        int dev = 0, cus = 0, per_cu = 0;
        hipGetDevice(&dev);
        hipDeviceGetAttribute(&cus, hipDeviceAttributeMultiprocessorCount, dev);
        hipFuncSetAttribute((const void*)mega_kernel, hipFuncAttributeMaxDynamicSharedMemorySize, SMEM_BYTES + 16);
        hipOccupancyMaxActiveBlocksPerMultiprocessor(&per_cu, mega_kernel, NT, SMEM_BYTES + 16);
        if (per_cu > 1) per_cu = 1;
        if (per_cu < 1) per_cu = 1;
        grid_blocks = cus * per_cu;
    }
    hipMemsetAsync(p.bar, 0, (4096 + 64 * 7) * 4, stream);
    void* args[] = {&p};
    hipError_t e = hipLaunchCooperativeKernel((void*)mega_kernel, dim3(grid_blocks), dim3(NT), args, SMEM_BYTES + 16, stream);
    if (e != hipSuccess) fprintf(stderr, "cooperative launch failed: %s (grid %d)\n", hipGetErrorString(e), grid_blocks);
#endif
}
```
